# Optimizing an MI355X kernel written in HIP

```python
import math
import jax
import jax.numpy as jnp
from jax import lax
import numpy as np

D_MODEL = 2048
BATCH = 4
SEQ = 4096
DEPTH = 2

HEAD_DIM = 128
ROPE_THETA = 10000.0
ATTN_Q_BLOCK = 128
NEG = -1e30
LN_EPS = 1e-5
DN_ALPHA = (2 * DEPTH) ** 0.25
DN_BETA = (8 * DEPTH) ** -0.25

DIFF_HEADS = D_MODEL // (2 * HEAD_DIM)
DIFF_QK_DIM = HEAD_DIM // 2
MOBA_HEADS = D_MODEL // (2 * HEAD_DIM)
MOBA_BLOCK = 256
MOBA_TOPK = 3
MOBA_Q_CHUNK = 32
NSA_HEADS = D_MODEL // HEAD_DIM
NSA_KV_GROUPS = 2
NSA_CMP_LEN = 32
NSA_CMP_STRIDE = 16
NSA_SEL_BLOCK = 64
NSA_SEL_N = 16
NSA_WINDOW = 512
NSA_Q_CHUNK = 32
NSA_FORCED = 1e4
N_EXPERTS = 64
EXPERT_DIM = 512
TOP_K = 8
N_GROUPS = 8
TOPK_GROUPS = 4
ROUTED_SCALE = 2.5
MOE_CHUNK = 512

MIX_WIDTH = (DIFF_HEADS + MOBA_HEADS) * HEAD_DIM
L0_SPLITS = (DIFF_HEADS * 2 * DIFF_QK_DIM, DIFF_HEADS * 2 * DIFF_QK_DIM, DIFF_HEADS * HEAD_DIM,
             MOBA_HEADS * HEAD_DIM, MOBA_HEADS * HEAD_DIM, MOBA_HEADS * HEAD_DIM)
L1_SPLITS = (NSA_HEADS * HEAD_DIM,) + (NSA_KV_GROUPS * HEAD_DIM,) * 6 + (NSA_HEADS * 3,)

kernel_name = 'hybrid_diff_moba_nsa_moe_deepnorm'


def _split(t, sizes):
    return jnp.split(t, np.cumsum(sizes)[:-1].tolist(), axis=-1)


def layernorm(x, g, b):
    xf = x.astype(jnp.float32)
    mu = jnp.mean(xf, axis=-1, keepdims=True)
    var = jnp.mean(jnp.square(xf - mu), axis=-1, keepdims=True)
    return ((xf - mu) * lax.rsqrt(var + LN_EPS) * g + b).astype(x.dtype)


def rope(x, pos):
    d = x.shape[-1]
    half = d // 2
    inv = ROPE_THETA ** (-jnp.arange(half, dtype=jnp.float32) * 2.0 / d)
    ang = pos.astype(jnp.float32)[:, None] * inv[None, :]
    cos, sin = jnp.cos(ang), jnp.sin(ang)
    xf = x.astype(jnp.float32)
    x1, x2 = xf[..., :half], xf[..., half:]
    return jnp.concatenate([x1 * cos - x2 * sin, x2 * cos + x1 * sin], axis=-1).astype(x.dtype)


def diff_attention_group(q, k, v, lam_q1, lam_k1, lam_q2, lam_k2, subln_g, pos, layer_idx):
    B, S, _ = q.shape
    H, dq = DIFF_HEADS, DIFF_QK_DIM
    f32 = jnp.float32
    q = rope(q.reshape(B, S, H, 2, dq).transpose(3, 0, 2, 1, 4), pos)
    k = rope(k.reshape(B, S, H, 2, dq).transpose(3, 0, 2, 1, 4), pos)
    v = v.reshape(B, S, H, HEAD_DIM).transpose(0, 2, 1, 3)
    lam_init = 0.8 - 0.6 * math.exp(-0.3 * layer_idx)
    lam = (jnp.exp(jnp.sum(lam_q1.astype(f32) * lam_k1.astype(f32)))
           - jnp.exp(jnp.sum(lam_q2.astype(f32) * lam_k2.astype(f32))) + lam_init)
    scale = dq ** -0.5
    kpos = jnp.arange(S)

    def q_block(i):
        st = i * ATTN_Q_BLOCK
        qb = lax.dynamic_slice_in_dim(q, st, ATTN_Q_BLOCK, axis=3)
        qpos = st + jnp.arange(ATTN_Q_BLOCK)
        mask = kpos[None, :] <= qpos[:, None]
        s = jnp.einsum('mbhqd,mbhkd->mbhqk', qb, k).astype(f32) * scale
        p = jax.nn.softmax(jnp.where(mask, s, NEG), axis=-1)
        a = p[0] - lam * p[1]
        return jnp.einsum('bhqk,bhkd->bhqd', a.astype(v.dtype), v)

    o = lax.map(q_block, jnp.arange(S // ATTN_Q_BLOCK))
    o = o.transpose(1, 2, 0, 3, 4).reshape(B, H, S, HEAD_DIM).astype(f32)
    o = o * lax.rsqrt(jnp.mean(jnp.square(o), axis=-1, keepdims=True) + LN_EPS) * subln_g * (1.0 - lam_init)
    return o.astype(v.dtype).transpose(0, 2, 1, 3).reshape(B, S, H * HEAD_DIM)


def moba_group(q, k, v, pos):
    B, S, _ = q.shape
    H, D, BLK, C = MOBA_HEADS, HEAD_DIM, MOBA_BLOCK, MOBA_Q_CHUNK
    f32 = jnp.float32
    heads = lambda t: t.reshape(B, S, H, D).transpose(0, 2, 1, 3)
    q, k, v = rope(heads(q), pos), rope(heads(k), pos), heads(v)
    nb = -(-S // BLK)
    pad = nb * BLK - S
    padw = ((0, 0), (0, 0), (0, pad), (0, 0))
    q, k, v = jnp.pad(q, padw), jnp.pad(k, padw), jnp.pad(v, padw)
    kb = k.reshape(B, H, nb, BLK, D)
    vb = v.reshape(B, H, nb, BLK, D)
    kmean = jnp.mean(kb.astype(f32), axis=3)
    n_pick = max(1, min(MOBA_TOPK, nb - 1))
    n_sel_keys = n_pick * BLK
    scale = D ** -0.5
    bi = jnp.arange(B)[:, None, None, None]
    hi = jnp.arange(H)[None, :, None, None]
    blk_ids = jnp.arange(nb)

    def q_chunk(c):
        st = c * C
        qc = lax.dynamic_slice_in_dim(q, st, C, axis=2)
        qpos = st + jnp.arange(C)
        own = st // BLK
        gate = jnp.einsum('bhqd,bhnd->bhqn', qc.astype(f32), kmean)
        gate = jnp.where(blk_ids < own, gate, NEG)
        _, idx = lax.top_k(gate, n_pick)
        picked = jnp.repeat(idx < own, BLK, axis=-1)
        k_sel = kb[bi, hi, idx].reshape(B, H, C, n_sel_keys, D)
        v_sel = vb[bi, hi, idx].reshape(B, H, C, n_sel_keys, D)
        k_own = lax.dynamic_index_in_dim(kb, own, axis=2, keepdims=False)
        v_own = lax.dynamic_index_in_dim(vb, own, axis=2, keepdims=False)
        own_mask = (own * BLK + jnp.arange(BLK))[None, :] <= qpos[:, None]
        s_sel = jnp.einsum('bhqd,bhqkd->bhqk', qc, k_sel).astype(f32) * scale
        s_own = jnp.einsum('bhqd,bhkd->bhqk', qc, k_own).astype(f32) * scale
        s = jnp.concatenate([jnp.where(picked, s_sel, NEG), jnp.where(own_mask, s_own, NEG)], axis=-1)
        p = jax.nn.softmax(s, axis=-1).astype(v.dtype)
        return (jnp.einsum('bhqk,bhqkd->bhqd', p[..., :n_sel_keys], v_sel)
                + jnp.einsum('bhqk,bhkd->bhqd', p[..., n_sel_keys:], v_own))

    o = lax.map(q_chunk, jnp.arange(nb * BLK // C))
    o = o.transpose(1, 2, 0, 3, 4).reshape(B, H, nb * BLK, D)[:, :, :S]
    return o.transpose(0, 2, 1, 3).reshape(B, S, H * D)


def diff_moba_mixer(h, w_in, lam_q1, lam_k1, lam_q2, lam_k2, subln_g, w_out, layer_idx):
    S = h.shape[1]
    pos = jnp.arange(S)
    dq, dk, dv, mq, mk, mv = _split(h @ w_in, L0_SPLITS)
    o_a = diff_attention_group(dq, dk, dv, lam_q1, lam_k1, lam_q2, lam_k2, subln_g, pos, layer_idx)
    o_b = moba_group(mq, mk, mv, pos)
    return jnp.concatenate([o_a, o_b], axis=-1) @ w_out


def nsa_mixer(h, w_in, pe_k, w1_k, w2_k, pe_v, w1_v, w2_v, w_out):
    B, S, _ = h.shape
    H, G, D = NSA_HEADS, NSA_KV_GROUPS, HEAD_DIM
    R = H // G
    f32 = jnp.float32
    q, kc, vc, ks, vs, kw, vw, gl = _split(h @ w_in, L1_SPLITS)
    pos = jnp.arange(S)
    scale = D ** -0.5
    q = q.reshape(B, S, G, R, D).transpose(0, 2, 3, 1, 4)
    q_rot = rope(q, pos)
    kv_heads = lambda t: t.reshape(B, S, G, D).transpose(0, 2, 1, 3)

    n_cmp = (S - NSA_CMP_LEN) // NSA_CMP_STRIDE + 1
    cmp_start = jnp.arange(n_cmp) * NSA_CMP_STRIDE
    gather_idx = cmp_start[:, None] + jnp.arange(NSA_CMP_LEN)[None, :]

    def compress(t, pe, w1, w2):
        blocks = kv_heads(t)[:, :, gather_idx] + pe
        hid = jax.nn.gelu(blocks.reshape(B, G, n_cmp, NSA_CMP_LEN * D) @ w1)
        return hid @ w2

    k_cmp = compress(kc, pe_k, w1_k, w2_k)
    v_cmp = compress(vc, pe_v, w1_v, w2_v)
    cmp_mask = (cmp_start + NSA_CMP_LEN - 1)[None, :] <= pos[:, None]
    s_c = jnp.einsum('bgrsd,bgnd->bgrsn', q, k_cmp).astype(f32) * scale
    p_c = jax.nn.softmax(jnp.where(cmp_mask, s_c, NEG), axis=-1) * cmp_mask
    o_cmp = jnp.einsum('bgrsn,bgnd->bgrsd', p_c.astype(v_cmp.dtype), v_cmp).astype(f32)

    n_blk = S // NSA_SEL_BLOCK
    blk_start = jnp.arange(n_blk) * NSA_SEL_BLOCK
    overlap = jnp.clip(jnp.minimum(cmp_start[:, None] + NSA_CMP_LEN, blk_start[None, :] + NSA_SEL_BLOCK)
                       - jnp.maximum(cmp_start[:, None], blk_start[None, :]), 0).astype(f32) / NSA_CMP_LEN
    imp = jnp.einsum('bgrsn,nj->bgsj', p_c, overlap)
    cur = pos // NSA_SEL_BLOCK
    blk = jnp.arange(n_blk)[None, :]
    allowed = blk <= cur[:, None]
    forced = (blk == 0) | (blk == cur[:, None]) | (blk == cur[:, None] - 1)
    imp = jnp.where(allowed, jnp.where(forced, NSA_FORCED, imp), NEG)
    n_pick = min(NSA_SEL_N, n_blk)
    _, sel_idx = lax.top_k(imp, n_pick)
    k_slc = rope(kv_heads(ks), pos).reshape(B, G, n_blk, NSA_SEL_BLOCK, D)
    v_slc = kv_heads(vs).reshape(B, G, n_blk, NSA_SEL_BLOCK, D)
    n_keys = n_pick * NSA_SEL_BLOCK
    bi = jnp.arange(B)[:, None, None, None]
    gi = jnp.arange(G)[None, :, None, None]

    def sel_chunk(c):
        st = c * NSA_Q_CHUNK
        qc = lax.dynamic_slice_in_dim(q_rot, st, NSA_Q_CHUNK, axis=3)
        idx = lax.dynamic_slice_in_dim(sel_idx, st, NSA_Q_CHUNK, axis=2)
        kg = k_slc[bi, gi, idx].reshape(B, G, NSA_Q_CHUNK, n_keys, D)
        vg = v_slc[bi, gi, idx].reshape(B, G, NSA_Q_CHUNK, n_keys, D)
        qpos = st + jnp.arange(NSA_Q_CHUNK)
        kpos = (idx[..., None] * NSA_SEL_BLOCK + jnp.arange(NSA_SEL_BLOCK)).reshape(B, G, NSA_Q_CHUNK, n_keys)
        m = kpos <= qpos[None, None, :, None]
        s = jnp.einsum('bgrqd,bgqkd->bgrqk', qc, kg).astype(f32) * scale
        p = jax.nn.softmax(jnp.where(m[:, :, None], s, NEG), axis=-1)
        return jnp.einsum('bgrqk,bgqkd->bgrqd', p.astype(vg.dtype), vg)

    o_sel = lax.map(sel_chunk, jnp.arange(S // NSA_Q_CHUNK))
    o_sel = o_sel.transpose(1, 2, 3, 0, 4, 5).reshape(B, G, R, S, D).astype(f32)

    padw = ((0, 0), (0, 0), (NSA_WINDOW, 0), (0, 0))
    k_win = jnp.pad(rope(kv_heads(kw), pos), padw)
    v_win = jnp.pad(kv_heads(vw), padw)
    band = NSA_WINDOW + ATTN_Q_BLOCK

    def win_block(i):
        st = i * ATTN_Q_BLOCK
        qb = lax.dynamic_slice_in_dim(q_rot, st, ATTN_Q_BLOCK, axis=3)
        kb = lax.dynamic_slice_in_dim(k_win, st, band, axis=2)
        vb = lax.dynamic_slice_in_dim(v_win, st, band, axis=2)
        kpos = st - NSA_WINDOW + jnp.arange(band)
        qpos = st + jnp.arange(ATTN_Q_BLOCK)
        m = ((kpos[None, :] <= qpos[:, None]) & (kpos[None, :] > qpos[:, None] - NSA_WINDOW)
             & (kpos[None, :] >= 0))
        s = jnp.einsum('bgrqd,bgkd->bgrqk', qb, kb).astype(f32) * scale
        p = jax.nn.softmax(jnp.where(m, s, NEG), axis=-1)
        return jnp.einsum('bgrqk,bgkd->bgrqd', p.astype(vb.dtype), vb)

    o_win = lax.map(win_block, jnp.arange(S // ATTN_Q_BLOCK))
    o_win = o_win.transpose(1, 2, 3, 0, 4, 5).reshape(B, G, R, S, D).astype(f32)

    g = jax.nn.sigmoid(gl.astype(f32)).reshape(B, S, G, R, 3).transpose(0, 2, 3, 1, 4)
    o = (g[..., 0:1] * o_cmp + g[..., 1:2] * o_sel + g[..., 2:3] * o_win).astype(h.dtype)
    return o.transpose(0, 3, 1, 2, 4).reshape(B, S, H * D) @ w_out


def moe(h, router_w, router_b, w_gu, w_down, ws_gu, ws_down):
    B, S, Dm = h.shape
    T = B * S
    f32 = jnp.float32
    xt = h.reshape(T, Dm)
    score = jax.nn.sigmoid((xt @ router_w).astype(f32))
    biased = score + router_b.astype(f32)
    grp_score = lax.top_k(biased.reshape(T, N_GROUPS, N_EXPERTS // N_GROUPS), 2)[0].sum(-1)
    _, gidx = lax.top_k(grp_score, TOPK_GROUPS)
    gmask = jnp.any(gidx[:, :, None] == jnp.arange(N_GROUPS), axis=1)
    emask = jnp.repeat(gmask, N_EXPERTS // N_GROUPS, axis=1)
    _, eidx = lax.top_k(jnp.where(emask, biased, NEG), TOP_K)
    w = jnp.take_along_axis(score, eidx, axis=1)
    w = w / jnp.sum(w, axis=-1, keepdims=True) * ROUTED_SCALE

    n_slots = T * TOP_K
    flat_e = eidx.reshape(-1)
    flat_t = jnp.repeat(jnp.arange(T, dtype=jnp.int32), TOP_K)
    flat_w = w.reshape(-1)
    order = jnp.argsort(flat_e)
    se = flat_e[order]
    counts = jnp.bincount(flat_e, length=N_EXPERTS)
    pcounts = (counts + MOE_CHUNK - 1) // MOE_CHUNK * MOE_CHUNK
    pend = jnp.cumsum(pcounts)
    pstart = pend - pcounts
    cstart = jnp.cumsum(counts) - counts
    dest = pstart[se] + (jnp.arange(n_slots) - cstart[se])
    n_rows = (-(-n_slots // MOE_CHUNK)) * MOE_CHUNK + N_EXPERTS * MOE_CHUNK
    n_chunks = n_rows // MOE_CHUNK
    buf_t = jnp.zeros((n_rows,), jnp.int32).at[dest].set(flat_t[order])
    buf_w = jnp.zeros((n_rows,), xt.dtype).at[dest].set(flat_w[order].astype(xt.dtype))
    chunk_e = jnp.clip(jnp.searchsorted(pend, jnp.arange(n_chunks) * MOE_CHUNK, side='right'), 0, N_EXPERTS - 1)

    def expert_chunk(acc, inp):
        tok, wt, e = inp
        gate, up = jnp.split(xt[tok] @ w_gu[e], 2, axis=-1)
        y = (jax.nn.silu(gate) * up) @ w_down[e]
        return acc.at[tok].add(y * wt[:, None]), None

    routed, _ = lax.scan(expert_chunk, jnp.zeros_like(xt),
                         (buf_t.reshape(n_chunks, MOE_CHUNK), buf_w.reshape(n_chunks, MOE_CHUNK), chunk_e))
    sg, su = jnp.split(xt @ ws_gu, 2, axis=-1)
    shared = (jax.nn.silu(sg) * su) @ ws_down
    return (routed + shared).reshape(B, S, Dm)


def setup_inputs(seed: int = 0) -> dict:
    key = jax.random.key(seed)
    k = jax.random.split(key, 32)
    nrm = lambda i, shape, s: jax.random.normal(k[i], shape, jnp.float32) * s
    NE = (DEPTH + 1) // 2
    NO = DEPTH // 2
    D = D_MODEL
    L0_IN = sum(L0_SPLITS)
    L1_IN = sum(L1_SPLITS)
    CMP_IN = NSA_CMP_LEN * HEAD_DIM
    return {
        'x': nrm(0, (BATCH, SEQ, D), 1.0),
        'a_w_in': nrm(1, (NE, D, L0_IN), D ** -0.5),
        'a_lam_q1': nrm(2, (NE, DIFF_QK_DIM), 0.1),
        'a_lam_k1': nrm(3, (NE, DIFF_QK_DIM), 0.1),
        'a_lam_q2': nrm(4, (NE, DIFF_QK_DIM), 0.1),
        'a_lam_k2': nrm(5, (NE, DIFF_QK_DIM), 0.1),
        'a_subln_g': 1.0 + nrm(6, (NE, HEAD_DIM), 0.02),
        'a_w_out': nrm(7, (NE, MIX_WIDTH, D), MIX_WIDTH ** -0.5 * DN_BETA),
        'c_w_in': nrm(8, (NO, D, L1_IN), D ** -0.5),
        'c_pe_k': nrm(9, (NO, NSA_CMP_LEN, HEAD_DIM), 0.02),
        'c_w1_k': nrm(10, (NO, CMP_IN, HEAD_DIM), CMP_IN ** -0.5),
        'c_w2_k': nrm(11, (NO, HEAD_DIM, HEAD_DIM), HEAD_DIM ** -0.5),
        'c_pe_v': nrm(12, (NO, NSA_CMP_LEN, HEAD_DIM), 0.02),
        'c_w1_v': nrm(13, (NO, CMP_IN, HEAD_DIM), CMP_IN ** -0.5),
        'c_w2_v': nrm(14, (NO, HEAD_DIM, HEAD_DIM), HEAD_DIM ** -0.5),
        'c_w_out': nrm(15, (NO, NSA_HEADS * HEAD_DIM, D), (NSA_HEADS * HEAD_DIM) ** -0.5 * DN_BETA),
        'ln_mix_g': 1.0 + nrm(16, (DEPTH, D), 0.02),
        'ln_mix_b': nrm(17, (DEPTH, D), 0.02),
        'ln_ffn_g': 1.0 + nrm(18, (DEPTH, D), 0.02),
        'ln_ffn_b': nrm(19, (DEPTH, D), 0.02),
        'router_w': nrm(20, (DEPTH, D, N_EXPERTS), D ** -0.5),
        'router_b': nrm(21, (DEPTH, N_EXPERTS), 0.01),
        'w_gu': nrm(22, (DEPTH, N_EXPERTS, D, 2 * EXPERT_DIM), D ** -0.5),
        'w_down': nrm(23, (DEPTH, N_EXPERTS, EXPERT_DIM, D), EXPERT_DIM ** -0.5 * DN_BETA),
        'ws_gu': nrm(24, (DEPTH, D, 2 * EXPERT_DIM), D ** -0.5),
        'ws_down': nrm(25, (DEPTH, EXPERT_DIM, D), EXPERT_DIM ** -0.5 * DN_BETA),
    }


def reference(x, a_w_in, a_lam_q1, a_lam_k1, a_lam_q2, a_lam_k2, a_subln_g, a_w_out,
              c_w_in, c_pe_k, c_w1_k, c_w2_k, c_pe_v, c_w1_v, c_w2_v, c_w_out,
              ln_mix_g, ln_mix_b, ln_ffn_g, ln_ffn_b,
              router_w, router_b, w_gu, w_down, ws_gu, ws_down):
    h = x
    for i in range(DEPTH):
        j = i // 2
        if i % 2 == 0:
            mix = diff_moba_mixer(h, a_w_in[j], a_lam_q1[j], a_lam_k1[j], a_lam_q2[j], a_lam_k2[j],
                                  a_subln_g[j], a_w_out[j], i)
        else:
            mix = nsa_mixer(h, c_w_in[j], c_pe_k[j], c_w1_k[j], c_w2_k[j], c_pe_v[j], c_w1_v[j], c_w2_v[j],
                            c_w_out[j])
        h = layernorm(DN_ALPHA * h + mix, ln_mix_g[i], ln_mix_b[i])
        ffn = moe(h, router_w[i], router_b[i], w_gu[i], w_down[i], ws_gu[i], ws_down[i])
        h = layernorm(DN_ALPHA * h + ffn, ln_ffn_g[i], ln_ffn_b[i])
    return h
```

```cpp
#include <hip/hip_runtime.h>
#include <cstdio>
#include <cstdint>

#ifndef MK_N_LAUNCHES
#define MK_N_LAUNCHES 1
#endif

#define LAS __attribute__((address_space(3)))
#define GAS __attribute__((address_space(1)))
typedef unsigned short bf16_t;
typedef short bf16x8 __attribute__((ext_vector_type(8)));
typedef short s16x4 __attribute__((ext_vector_type(4)));
typedef float f32x4 __attribute__((ext_vector_type(4)));
typedef float f32x2 __attribute__((ext_vector_type(2)));
typedef float f32x16 __attribute__((ext_vector_type(16)));
typedef unsigned u32x4 __attribute__((ext_vector_type(4)));
typedef unsigned u32x2 __attribute__((ext_vector_type(2)));
typedef int i32x8 __attribute__((ext_vector_type(8)));

constexpr int NB = 4, SEQ = 4096, T = NB * SEQ, DM = 2048;
constexpr int NEXP = 64, EDIM = 512, TOPK = 8, NGRP = 8, TOPKG = 4;
constexpr int N0 = 6144, N1 = 3840, N1R = 3632;
constexpr float DN_ALPHA = 1.41421356237309515f;
constexpr float LN_EPS = 1e-5f;
constexpr float NEGF = -1e30f;
constexpr float NEGS = -60000.0f;
constexpr int MAXTILES = 640;
constexpr int NPHASE = 17;

constexpr size_t al256(size_t x) { return (x + 255) & ~(size_t)255; }
constexpr size_t WS_CTL = 0, CTL_BYTES = 1u << 20;
constexpr size_t WS_ROPE128 = WS_CTL + CTL_BYTES;
constexpr size_t WS_ROPE64 = WS_ROPE128 + (size_t)SEQ * 64 * 8;
constexpr size_t WS_PEB = WS_ROPE64 + (size_t)SEQ * 32 * 8;
constexpr size_t WS_WAIN = WS_PEB + 4096;
constexpr size_t WS_WAOUT = WS_WAIN + (size_t)N0 * DM * 2;
constexpr size_t WS_WCIN = WS_WAOUT + (size_t)DM * DM * 2;
constexpr size_t WS_WCOUT = WS_WCIN + (size_t)N1 * DM * 2;
constexpr size_t WS_W1KT = WS_WCOUT + (size_t)DM * DM * 2;
constexpr size_t WS_W1VT = WS_W1KT + (size_t)128 * 4096 * 2;
constexpr size_t WS_W2KT = WS_W1VT + (size_t)128 * 4096 * 2;
constexpr size_t WS_W2VT = WS_W2KT + (size_t)128 * 128 * 2;
constexpr size_t WS_WRT = WS_W2VT + (size_t)128 * 128 * 2;
constexpr size_t WS_WGU = WS_WRT + (size_t)2 * 64 * DM * 2;
constexpr size_t WGU_E = (size_t)1024 * DM * 2;
constexpr size_t WS_WDN = WS_WGU + (size_t)2 * 65 * WGU_E;
constexpr size_t WDN_E = (size_t)DM * EDIM * 2;
constexpr size_t WS_XB = WS_WDN + (size_t)2 * 65 * WDN_E;
constexpr size_t WS_QKV = WS_XB + (size_t)T * DM * 2;
constexpr size_t WS_QROT = WS_QKV + (size_t)(T + 64) * N0 * 2;
constexpr size_t WS_KMEAN = WS_QROT + (size_t)T * DM * 2;
constexpr size_t WS_KCMP = WS_KMEAN + (size_t)NB * 8 * 32 * 128 * 2;
constexpr size_t WS_VCMP = WS_KCMP + (size_t)8 * 256 * 128 * 2;
constexpr size_t WS_ATT = WS_VCMP + (size_t)8 * 256 * 128 * 2;
constexpr size_t WS_Y1 = WS_ATT + (size_t)T * DM * 2;
constexpr size_t WS_STATS = WS_Y1 + (size_t)T * DM * 4;
constexpr size_t WS_HB = WS_STATS + (size_t)T * 8;
constexpr size_t WS_TOKE = WS_HB + (size_t)T * DM * 2;
constexpr size_t WS_TOKP = WS_TOKE + (size_t)T * 8 * 4;
constexpr size_t WS_TOKW = WS_TOKP + (size_t)T * 8 * 4;
constexpr size_t WS_LIST = WS_TOKW + (size_t)T * 8 * 4;
constexpr size_t WS_HBUF = WS_LIST + (size_t)NEXP * T * 4;
constexpr size_t WS_YBUF = WS_HBUF + (size_t)MAXTILES * 256 * EDIM * 2;
constexpr size_t WS_H2F = WS_YBUF + (size_t)MAXTILES * 256 * DM * 2;
constexpr size_t WS_HB8 = WS_H2F + (size_t)T * DM * 4;
constexpr size_t WS_END = WS_HB8 + (size_t)T * DM;
constexpr int CW_BAR = 4096;
constexpr int CW_QNEXT = 65536, CW_DONE = 65536 + 64;
constexpr int CW_CNT = 8192;

constexpr int RING_BYTES = 131072;
constexpr int MISC_OFF = RING_BYTES;
constexpr int LDS_BYTES = 147456;
constexpr int MO_BARW = 0;
constexpr int MO_TPRE = 64;
constexpr int MO_CNT = 64 + 66 * 4;
constexpr int MO_ETAB = 1024;
constexpr int MO_GEN = 2048;

#define LDS_WAIT() asm volatile("s_waitcnt lgkmcnt(0)" ::: "memory")
#define VM_WAIT() asm volatile("s_waitcnt vmcnt(0)" ::: "memory")
#define SBAR() __builtin_amdgcn_sched_barrier(0)
typedef __bf16 bf16x2_t __attribute__((ext_vector_type(2)));
__device__ __forceinline__ unsigned cvt_pk_bf16(float lo, float hi) { const f32x2 v = {lo, hi}; return __builtin_bit_cast(unsigned, __builtin_convertvector(v, bf16x2_t)); }
__device__ __forceinline__ unsigned pk_fp8x4(float a, float b, float c, float d) { int w = __builtin_amdgcn_cvt_pk_fp8_f32(a, b, 0, false); w = __builtin_amdgcn_cvt_pk_fp8_f32(c, d, w, true); return (unsigned)w; }
constexpr float F8_WSCALE = 64.0f, F8_HSCALE = 16.0f, F8_YSCALE = 16.0f;
__device__ __forceinline__ float bf2f(unsigned short b) { return __uint_as_float(((unsigned)b) << 16); }
__device__ __forceinline__ float bflo(unsigned w) { return __uint_as_float(w << 16); }
__device__ __forceinline__ float bfhi(unsigned w) { return __uint_as_float(w & 0xffff0000u); }
template <int K> __device__ __forceinline__ float swz_xor(float v) { return __int_as_float(__builtin_amdgcn_ds_swizzle(__float_as_int(v), (K << 10) | 0x1f)); }
struct F2 { float own_lo, own_hi; };
__device__ __forceinline__ float sum32(float v) { auto r = __builtin_amdgcn_permlane32_swap(__float_as_uint(v), __float_as_uint(v), false, false); return __uint_as_float(r[0]) + __uint_as_float(r[1]); }
__device__ __forceinline__ float max32(float v) { auto r = __builtin_amdgcn_permlane32_swap(__float_as_uint(v), __float_as_uint(v), false, false); return fmaxf(__uint_as_float(r[0]), __uint_as_float(r[1])); }
__device__ __forceinline__ float partner32(float v, int h) { auto r = __builtin_amdgcn_permlane32_swap(__float_as_uint(v), __float_as_uint(v), false, false); return __uint_as_float(h ? r[0] : r[1]); }
__device__ __forceinline__ float wave_sum(float v) {
    v += swz_xor<1>(v); v += swz_xor<2>(v); v += swz_xor<4>(v); v += swz_xor<8>(v); v += swz_xor<16>(v);
    return sum32(v);
}
__device__ __forceinline__ float fast_exp2(float x) { return __builtin_amdgcn_exp2f(x); }
__device__ __forceinline__ float fast_rcp(float x) { return __builtin_amdgcn_rcpf(x); }

__device__ __forceinline__ int fresh_lane() { int l; asm volatile("v_mbcnt_lo_u32_b32 %0, -1, 0\n\tv_mbcnt_hi_u32_b32 %0, -1, %0" : "=v"(l)); return l; }
#define XB_TMO      128
#define XB_XCNT(j)  (256  + 64 * (j))
#define XB_XSUB(j)  (1280 + 64 * (j))
#define XB_XGEN(j)  (2304 + 64 * (j))
#define XB_TOP      3328
#define XB_TOPGEN   3392
#define XCD_BAR_WORDS 3456
#define XB_SPIN_CAP (1u << 21)
__device__ __forceinline__ unsigned xb_ld(unsigned* p)              { return __hip_atomic_load(p, __ATOMIC_RELAXED, __HIP_MEMORY_SCOPE_AGENT); }
__device__ __forceinline__ unsigned xb_add(unsigned* p, unsigned v) { return __hip_atomic_fetch_add(p, v, __ATOMIC_RELAXED, __HIP_MEMORY_SCOPE_AGENT); }
__device__ __forceinline__ unsigned xb_xcc_id() { return (unsigned)__builtin_amdgcn_s_getreg((3 << 11) | 20) & 0xFu; }
#define XB_SPIN(cond, bar) do { unsigned _sp = 0; while (cond) { __builtin_amdgcn_s_sleep(1); \
    if ((++_sp & 255u) == 0u) { if (xb_ld(&(bar)[XB_TMO])) break; if (_sp > XB_SPIN_CAP) { atomicAdd(&(bar)[XB_TMO], 1u); break; } } } } while (0)
struct XcdBarrier { unsigned* bar; unsigned x; volatile LAS unsigned* st; int wave; };
__device__ __forceinline__ XcdBarrier xcd_barrier_post(unsigned* bar, volatile LAS unsigned* st) {
    XcdBarrier b; b.bar = bar; b.x = xb_xcc_id(); b.st = st; b.wave = 0;
    if (threadIdx.x == 0) (void)xb_add(&bar[XB_XCNT(b.x)], 1u);
    return b;
}
__device__ __forceinline__ void xcd_barrier_complete(unsigned* bar, unsigned x, unsigned& nloc, unsigned& nx) {
    const unsigned G = gridDim.x * gridDim.y * gridDim.z;
    unsigned sum, cnt, mine, sp = 0u;
    for (;;) {
        sum = 0u; cnt = 0u; mine = 0u;
#pragma unroll
        for (unsigned j = 0; j < 16; ++j) { const unsigned c = xb_ld(&bar[XB_XCNT(j)]); sum += c; cnt += (c > 0u) ? 1u : 0u; mine = (j == x) ? c : mine; }
        if (sum == G) break;
        __builtin_amdgcn_s_sleep(1);
        if ((++sp & 255u) == 0u) { if (xb_ld(&bar[XB_TMO])) break; if (sp > XB_SPIN_CAP) { atomicAdd(&bar[XB_TMO], 1u); break; } }
    }
    nloc = mine > 0u ? mine : 1u; nx = cnt > 0u ? cnt : 1u;
}
__device__ __forceinline__ void xcd_barrier(const XcdBarrier& b) {
    asm volatile("s_waitcnt vmcnt(0)" ::: "memory");
    __syncthreads();
    if (b.wave == 0 && fresh_lane() == 0) {
        unsigned long long bar_ = (unsigned long long)b.bar; asm volatile("" : "+s"(bar_));
        unsigned* bar = (unsigned*)(GAS unsigned*)bar_;
        __builtin_amdgcn_s_waitcnt(0);
        unsigned nloc = b.st[0], nx = b.st[1];
        if (nloc == 0u) { xcd_barrier_complete(bar, b.x, nloc, nx); b.st[0] = nloc; b.st[1] = nx; }
        const unsigned old = xb_add(&bar[XB_XSUB(b.x)], 1u);
        const unsigned gen = old / nloc;
        if (old + 1u == (gen + 1u) * nloc) {
            __builtin_amdgcn_fence(__ATOMIC_RELEASE, "agent");
            asm volatile("s_waitcnt vmcnt(0)" ::: "memory");
            const unsigned og = xb_add(&bar[XB_TOP], 1u);
            const unsigned tg = og / nx;
            if (og + 1u == (tg + 1u) * nx) xb_add(&bar[XB_TOPGEN], 1u);
            else XB_SPIN(xb_ld(&bar[XB_TOPGEN]) == tg, bar);
            __builtin_amdgcn_fence(__ATOMIC_ACQUIRE, "agent");
            xb_add(&bar[XB_XGEN(b.x)], 1u);
            asm volatile("s_waitcnt vmcnt(0)" ::: "memory");
        } else {
            XB_SPIN(xb_ld(&bar[XB_XGEN(b.x)]) == gen, bar);
            __builtin_amdgcn_fence(__ATOMIC_ACQUIRE, "agent");
            asm volatile("s_waitcnt vmcnt(0)" ::: "memory");
        }
    }
    __syncthreads();
}
__device__ __forceinline__ void wg_self_visible(int wave) {
    asm volatile("s_waitcnt vmcnt(0)" ::: "memory");
    __syncthreads();
    if (wave == 0 && fresh_lane() == 0) { __builtin_amdgcn_fence(__ATOMIC_ACQUIRE, "agent"); asm volatile("s_waitcnt vmcnt(0)" ::: "memory"); }
    __syncthreads();
}

enum { MAP_ID = 0, MAP_PLAIN = 1, MAP_R128 = 2, MAP_R64 = 3 };
__host__ __device__ __forceinline__ int map_col(int type, int p) {
    const int wc = p >> 5, n = (p >> 4) & 1, fq = (p >> 2) & 3, e = p & 3;
    if (type == MAP_PLAIN) return 32 * wc + 8 * fq + 4 * n + e;
    if (type == MAP_R128) return 64 * n + 16 * wc + 4 * fq + e;
    if (type == MAP_R64) return 64 * (wc >> 1) + 32 * n + 16 * (wc & 1) + 4 * fq + e;
    return p;
}
enum { HT_PLAIN = 0, HT_R128 = 1, HT_R64 = 2, HT_RQ = 3, HT_SKIP = 4 };
__host__ __device__ __forceinline__ int ht_type(int layer, int ht) {
    if (layer == 0) { const int g = ht >> 3; return (g == 0 || g == 1) ? HT_R64 : ((g == 3 || g == 4) ? HT_R128 : HT_PLAIN); }
    if (ht < 16) return HT_RQ;
    if (ht == 20 || ht == 21 || ht == 24 || ht == 25) return HT_R128;
    if (ht == 29) return HT_SKIP;
    return HT_PLAIN;
}
__host__ __device__ __forceinline__ int ht_map(int t) { return t == HT_PLAIN || t == HT_SKIP ? MAP_PLAIN : (t == HT_R64 ? MAP_R64 : MAP_R128); }

namespace pg8 {
constexpr int BM = 256, BK = 64, HALF = 128, HTB = HALF * BK * 2, STAGE_BYTES = 8 * HTB, NXCD = 8, WGM = 8;
__host__ __device__ __forceinline__ int lds_byte(int r, int c) { const int st = (r >> 4) * 2 + (c >> 5), rr = r & 15, cc = c & 31, ob = rr * 64 + cc * 2; return st * 1024 + (ob ^ (((ob >> 9) & 1) << 5)); }
__host__ __device__ __forceinline__ void stage_rc(int b, int& R, int& C) { const int st = b / 1024, sb = b % 1024, swz = sb ^ (((sb >> 9) & 1) << 5); R = (st >> 1) * 16 + swz / 64; C = (st & 1) * 32 + (swz % 64) / 2; }

struct Unit { int pm, pn; const char* a; const char* b; int e, gt; };

struct DenseOrder {
    static constexpr bool PER_UNIT_OFFS = false;
    const char* A; const char* Bt; int RB, nM, nN, nwg, G, c;
    __device__ __forceinline__ void init(const void* A_, const void* Bt_, int M, int N, int K_, int G_, int c_) { A = (const char*)A_; Bt = (const char*)Bt_; RB = 2 * K_; nM = M / BM; nN = N / BM; nwg = nM * nN; G = G_; c = c_; }
    __device__ __forceinline__ bool next(int i, Unit& u) const {
        const long L = (long)i * G + c; if (L >= nwg) return false;
        int wgid = (int)L; { const int q = nwg / NXCD, r = nwg % NXCD, xcd = wgid % NXCD, off = wgid / NXCD; wgid = (xcd < r ? xcd * (q + 1) : r * (q + 1) + (xcd - r) * q) + off; }
        const int nig = WGM * nN, gid = wgid / nig, fm = gid * WGM, gsz = (nM - fm) < WGM ? (nM - fm) : WGM;
        u.pm = fm + ((wgid % nig) % gsz); u.pn = (wgid % nig) / gsz; u.e = 0; u.gt = u.pm;
        u.a = A + (size_t)u.pm * BM * RB; u.b = Bt + (size_t)u.pn * BM * RB; return true;
    }
    __device__ __forceinline__ void aoffs(const Unit&, const int (&R)[2], const int (&C)[2], unsigned (&v0)[2], unsigned (&v1)[2]) const {
#pragma unroll
        for (int i = 0; i < 2; ++i) { v0[i] = (unsigned)(R[i] * RB + 2 * C[i]); v1[i] = v0[i] + (unsigned)(HALF * RB); }
    }
};

template <class Epi, class Sched, bool FP8 = false>
__device__ __forceinline__ void gemm_phase(LAS unsigned char* lds, const int tid, const int RB  , const Sched& S, const Epi& E) {
    const int wid = __builtin_amdgcn_readfirstlane(tid >> 6), lane = tid & 63, wr = wid >> 2, wc = wid & 3, fr = lane & 15, fq = lane >> 4;
    const int nt = RB / 128;
    int sR[2], sC[2]; unsigned voffB[2];
#pragma unroll
    for (int i = 0; i < 2; ++i) { stage_rc(tid * 16 + i * 8192, sR[i], sC[i]); voffB[i] = (unsigned)(sR[i] * RB + 2 * sC[i]); }
    const size_t kstep = (size_t)(BK * 2);
    const size_t hstep = (size_t)HALF * RB;
    const unsigned ldsw = (unsigned)wid * 1024u;
    const int fcol = FP8 ? 32 * (fq >> 1) + 16 * (fq & 1) : fq * 8;
    const int aoff = lds_byte(wr * 64 + fr, fcol), boff = lds_byte(wc * 32 + fr, fcol);
#define PG8_SA(b, h) (((b) * 2 + (h)) * HTB)
#define PG8_SB(b, h) ((4 + (b) * 2 + (h)) * HTB)
#define PG8_STAGE(bufoff, gbase, voff) do { _Pragma("unroll") for (int _i = 0; _i < 2; ++_i) \
        __builtin_amdgcn_global_load_lds((const unsigned*)((const char*)(gbase) + (voff)[_i]), (LAS unsigned*)(lds + (bufoff) + ldsw + _i * 8192), 16, 0, 0); } while (0)
#define PG8_LDA(dst, b, h) do { _Pragma("unroll") for (int m = 0; m < 4; ++m) { if constexpr (FP8) dst##8[m] = *(const LAS i32x8*)(lds + PG8_SA(b, h) + aoff + m * 2048); else { _Pragma("unroll") for (int k = 0; k < 2; ++k) dst[m][k] = *(const LAS u32x4*)(lds + PG8_SA(b, h) + aoff + m * 2048 + k * 1024); } } } while (0)
#define PG8_LDB(dst, b, h) do { _Pragma("unroll") for (int n = 0; n < 2; ++n) { if constexpr (FP8) dst##8[n] = *(const LAS i32x8*)(lds + PG8_SB(b, h) + boff + n * 2048); else { _Pragma("unroll") for (int k = 0; k < 2; ++k) dst[n][k] = *(const LAS u32x4*)(lds + PG8_SB(b, h) + boff + n * 2048 + k * 1024); } } } while (0)
#define PG8_CAT(x) __builtin_shufflevector(__builtin_bit_cast(i32x4_t, (x)[0]), __builtin_bit_cast(i32x4_t, (x)[1]), 0, 1, 2, 3, 4, 5, 6, 7)
#define PG8_MMA(ai, bj, At, Bt) do { __builtin_amdgcn_s_setprio(1); _Pragma("unroll") for (int m = 0; m < 4; ++m) _Pragma("unroll") for (int n = 0; n < 2; ++n) { \
        if constexpr (FP8) acc[ai][bj][m][n] = __builtin_amdgcn_mfma_scale_f32_16x16x128_f8f6f4(Bt##8[n], At##8[m], acc[ai][bj][m][n], 0, 0, 0, 0x7f7f7f7f, 0, 0x7f7f7f7f); \
        else { _Pragma("unroll") for (int k = 0; k < 2; ++k) acc[ai][bj][m][n] = __builtin_amdgcn_mfma_f32_16x16x32_bf16(__builtin_bit_cast(bf16x8, Bt[n][k]), __builtin_bit_cast(bf16x8, At[m][k]), acc[ai][bj][m][n], 0, 0, 0); } } \
        __builtin_amdgcn_s_setprio(0); } while (0)
#define PG8_WAIT_V(n) asm volatile("s_waitcnt vmcnt(" #n ")" ::: "memory")
#define PG8_WAIT_L(n) asm volatile("s_waitcnt lgkmcnt(" #n ")" ::: "memory")
#define PG8_BAR __builtin_amdgcn_s_barrier()
#define PG8_SCHED __builtin_amdgcn_sched_barrier(0)
    Unit cur, nxt; int ui = 0;
    if (!S.next(0, cur)) return;
    f32x4 acc[2][2][4][2];
#pragma unroll
    for (int a = 0; a < 2; ++a)
#pragma unroll
        for (int b = 0; b < 2; ++b)
#pragma unroll
            for (int m = 0; m < 4; ++m)
#pragma unroll
                for (int n = 0; n < 2; ++n) acc[a][b][m][n] = (f32x4){0.f, 0.f, 0.f, 0.f};
    typedef int i32x4_t __attribute__((ext_vector_type(4)));
    u32x4 At[4][2], B0[2][2], B1[2][2]; i32x8 At8[4], B08[2], B18[2];
    unsigned vA0[2], vA1[2], nA0[2], nA1[2];
    S.aoffs(cur, sR, sC, vA0, vA1);
    const char* cA = cur.a; const char* cB = cur.b;
    PG8_STAGE(PG8_SB(0, 0), cB, voffB); PG8_STAGE(PG8_SA(0, 0), cA, vA0); PG8_STAGE(PG8_SB(0, 1), cB + hstep, voffB); PG8_STAGE(PG8_SA(0, 1), cA, vA1);
    if (wr == 1) PG8_BAR;
    PG8_WAIT_V(4); PG8_BAR;
    PG8_STAGE(PG8_SB(1, 0), cB + kstep, voffB); PG8_STAGE(PG8_SA(1, 0), cA + kstep, vA0); PG8_STAGE(PG8_SB(1, 1), cB + hstep + kstep, voffB);
    PG8_WAIT_V(6); PG8_BAR;
    Unit nn = cur; bool has_next = S.next(1, nxt); unsigned pA0[2], pA1[2];
    if constexpr (Sched::PER_UNIT_OFFS) {
        if (has_next) S.aoffs(nxt, sR, sC, nA0, nA1); else { nA0[0] = vA0[0]; nA0[1] = vA0[1]; nA1[0] = vA1[0]; nA1[1] = vA1[1]; }
        asm volatile("" : "+v"(nA0[0]), "+v"(nA0[1]), "+v"(nA1[0]), "+v"(nA1[1]));
    }
    for (;;) {
        if constexpr (!Sched::PER_UNIT_OFFS) { if (ui > 0) has_next = S.next(ui + 1, nxt); }
        const char* nA = has_next ? nxt.a : cA; const char* nB = has_next ? nxt.b : cB;
        for (int t = 0; t < nt; t += 2) {
            const bool last = (t == nt - 2);
            const char* a1 = cA + (size_t)(t + 1) * kstep;
            const char* a2 = last ? nA : cA + (size_t)(t + 2) * kstep; const char* b2 = last ? nB : cB + (size_t)(t + 2) * kstep;
            const char* a3 = a2 + kstep; const char* b3 = b2 + kstep;
            PG8_LDB(B0, 0, 0); PG8_SCHED; PG8_LDA(At, 0, 0); PG8_STAGE(PG8_SA(1, 1), a1, vA1);
            if constexpr (Sched::PER_UNIT_OFFS) { if (last) { vA0[0] = nA0[0]; vA0[1] = nA0[1]; vA1[0] = nA1[0]; vA1[1] = nA1[1]; } }
            PG8_WAIT_L(8); PG8_BAR; PG8_WAIT_L(0); PG8_MMA(0, 0, At, B0); PG8_BAR; PG8_SCHED;
            PG8_LDB(B1, 0, 1); PG8_STAGE(PG8_SB(0, 0), b2, voffB);
            PG8_BAR; PG8_WAIT_L(0); PG8_MMA(0, 1, At, B1); PG8_BAR;
            PG8_LDA(At, 0, 1); PG8_STAGE(PG8_SA(0, 0), a2, vA0);
            PG8_BAR; PG8_WAIT_L(0); PG8_MMA(1, 0, At, B0); PG8_BAR; PG8_SCHED;
            PG8_STAGE(PG8_SB(0, 1), b2 + hstep, voffB);
            PG8_WAIT_V(6); PG8_BAR; PG8_MMA(1, 1, At, B1); PG8_BAR;
            PG8_LDB(B0, 1, 0); PG8_SCHED; PG8_LDA(At, 1, 0); PG8_STAGE(PG8_SA(0, 1), a2, vA1);
            PG8_WAIT_L(8); PG8_BAR; PG8_WAIT_L(0); PG8_MMA(0, 0, At, B0); PG8_BAR; PG8_SCHED;
            PG8_LDB(B1, 1, 1); PG8_STAGE(PG8_SB(1, 0), b3, voffB);
            PG8_BAR; PG8_WAIT_L(0); PG8_MMA(0, 1, At, B1); PG8_BAR;
            PG8_LDA(At, 1, 1); PG8_STAGE(PG8_SA(1, 0), a3, vA0);
            PG8_BAR; PG8_WAIT_L(0); PG8_MMA(1, 0, At, B0); PG8_BAR; PG8_SCHED;
            PG8_STAGE(PG8_SB(1, 1), b3 + hstep, voffB);
            PG8_WAIT_V(6); PG8_BAR; PG8_MMA(1, 1, At, B1); PG8_BAR;
        }
        bool has_nn = false;
        if constexpr (Sched::PER_UNIT_OFFS) {
            has_nn = has_next && S.next(ui + 2, nn);
            if (has_nn) S.aoffs(nn, sR, sC, pA0, pA1); else { pA0[0] = nA0[0]; pA0[1] = nA0[1]; pA1[0] = nA1[0]; pA1[1] = nA1[1]; }
        }
        E(acc, cur, wr, wc, fr, fq);
        if (!has_next) break;
        if constexpr (Sched::PER_UNIT_OFFS) {
            asm volatile("" : "+v"(pA0[0]), "+v"(pA0[1]), "+v"(pA1[0]), "+v"(pA1[1]));
            nA0[0] = pA0[0]; nA0[1] = pA0[1]; nA1[0] = pA1[0]; nA1[1] = pA1[1];
        }
#pragma unroll
        for (int a = 0; a < 2; ++a)
#pragma unroll
            for (int b = 0; b < 2; ++b)
#pragma unroll
                for (int m = 0; m < 4; ++m)
#pragma unroll
                    for (int n = 0; n < 2; ++n) acc[a][b][m][n] = (f32x4){0.f, 0.f, 0.f, 0.f};
        cur = nxt; cA = nA; cB = nB; ++ui;
        if constexpr (Sched::PER_UNIT_OFFS) { nxt = nn; has_next = has_nn; }
    }
    PG8_WAIT_V(0);
    if (wr == 0) PG8_BAR;
    PG8_BAR;
#undef PG8_SA
#undef PG8_SB
#undef PG8_STAGE
#undef PG8_LDA
#undef PG8_LDB
#undef PG8_MMA
#undef PG8_WAIT_V
#undef PG8_WAIT_L
#undef PG8_BAR
#undef PG8_SCHED
}
}

struct MoeTabs { LAS const int* tpre; LAS const int* cnt; LAS const unsigned char* etab; int ntiles; };
__device__ __forceinline__ int xcd_remap(int L, int n) { constexpr int NXCD = pg8::NXCD; const int q = n / NXCD, r = n % NXCD, xcd = L % NXCD, off = L / NXCD; return (xcd < r ? xcd * (q + 1) : r * (q + 1) + (xcd - r) * q) + off; }
struct GuOrder {
    static constexpr bool PER_UNIT_OFFS = true;
    const char* A; const char* W; const int* list; MoeTabs tb; int G, c, RB;
    __device__ __forceinline__ bool next(int i, pg8::Unit& u) const {
        const long L0 = (long)i * G + c; const int nu = tb.ntiles * 4; if (L0 >= (long)nu) return false;
        const int L = xcd_remap((int)L0, nu);
        const int gt = (int)(L >> 2), pn = (int)(L & 3), e = __builtin_amdgcn_readfirstlane((int)tb.etab[gt]);
        u.gt = gt; u.e = e; u.pn = pn; u.pm = gt - __builtin_amdgcn_readfirstlane(tb.tpre[e]); u.a = A; u.b = W + (size_t)e * 1024 * RB + (size_t)pn * 256 * RB; return true;
    }
    __device__ __forceinline__ void aoffs(const pg8::Unit& u, const int (&R)[2], const int (&C)[2], unsigned (&v0)[2], unsigned (&v1)[2]) const {
        const int n = __builtin_amdgcn_readfirstlane(tb.cnt[u.e]);
#pragma unroll
        for (int i = 0; i < 2; ++i) {
            const int r0 = u.pm * 256 + R[i], r1 = r0 + 128;
            int t0 = 0, t1 = 0;
            if (u.e == NEXP) { t0 = r0; t1 = r1; }
            else { if (r0 < n) t0 = list[(size_t)u.e * T + r0]; if (r1 < n) t1 = list[(size_t)u.e * T + r1]; }
            v0[i] = (unsigned)(t0 * RB + 2 * C[i]); v1[i] = (unsigned)(t1 * RB + 2 * C[i]);
        }
    }
};
struct DnOrder {
    static constexpr bool PER_UNIT_OFFS = false;
    const char* H; const char* W; MoeTabs tb; int G, c, RB;
    __device__ __forceinline__ bool next(int i, pg8::Unit& u) const {
        const long L0 = (long)i * G + c; const int nu = tb.ntiles * 8; if (L0 >= (long)nu) return false;
        const int L = xcd_remap((int)L0, nu);
        const int gt = (int)(L >> 3), pn = (int)(L & 7), e = __builtin_amdgcn_readfirstlane((int)tb.etab[gt]);
        u.gt = gt; u.e = e; u.pn = pn; u.pm = gt; u.a = H + (size_t)gt * 256 * RB; u.b = W + (size_t)e * DM * RB + (size_t)pn * 256 * RB; return true;
    }
    __device__ __forceinline__ void aoffs(const pg8::Unit&, const int (&R)[2], const int (&C)[2], unsigned (&v0)[2], unsigned (&v1)[2]) const {
#pragma unroll
        for (int i = 0; i < 2; ++i) { v0[i] = (unsigned)(R[i] * RB + 2 * C[i]); v1[i] = v0[i] + (unsigned)(128 * RB); }
    }
};

__device__ __forceinline__ void pair_swap(u32x2& a, u32x2& b) {
    auto r0 = __builtin_amdgcn_permlane16_swap(a.x, b.x, false, false); a.x = r0[0]; b.x = r0[1];
    auto r1 = __builtin_amdgcn_permlane16_swap(a.y, b.y, false, false); a.y = r1[0]; b.y = r1[1];
}
struct EpiQKV {
    bf16_t* out; int ldo; bf16_t* qrot; const f32x4* rope128; const f32x4* rope64; int layer;
    template <int TYPE>
    __device__ __forceinline__ void half(const f32x4 (&acc)[2][2][4][2], const pg8::Unit& u, int bj, int ht, int wr, int wc, int fr, int fq) const {
        unsigned char* ob = (unsigned char*)out; unsigned char* qb = (unsigned char*)qrot; const unsigned char* r64 = (const unsigned char*)rope64; const unsigned char* r128 = (const unsigned char*)rope128;
#pragma unroll
        for (int ai = 0; ai < 2; ++ai) {
          f32x4 csa[4], csb[4];
          if constexpr (TYPE != HT_PLAIN) {
#pragma unroll
            for (int m = 0; m < 4; ++m) { const int row = u.pm * 256 + ai * 128 + wr * 64 + m * 16 + fr, pos = row & (SEQ - 1);
                if constexpr (TYPE == HT_R64) { const int i0 = 16 * (wc & 1) + 4 * fq; const unsigned o = (unsigned)((pos * 32 + i0) >> 1) * 16u; csa[m] = *(const f32x4*)(r64 + o); csb[m] = *(const f32x4*)(r64 + o + 16u); }
                else { const int i0 = 16 * wc + 4 * fq; const unsigned o = (unsigned)((pos * 64 + i0) >> 1) * 16u; csa[m] = *(const f32x4*)(r128 + o); csb[m] = *(const f32x4*)(r128 + o + 16u); } }
          }
#pragma unroll
            for (int m = 0; m < 4; ++m) {
                const int row = u.pm * 256 + ai * 128 + wr * 64 + m * 16 + fr;
                const f32x4 v0 = bj ? acc[ai][1][m][0] : acc[ai][0][m][0], v1 = bj ? acc[ai][1][m][1] : acc[ai][0][m][1];
                const unsigned oo = (unsigned)row * (unsigned)ldo * 2u + 256u * (unsigned)ht;
                if constexpr (TYPE == HT_PLAIN) {
                    u32x4 w; w.x = cvt_pk_bf16(v0[0], v0[1]); w.y = cvt_pk_bf16(v0[2], v0[3]); w.z = cvt_pk_bf16(v1[0], v1[1]); w.w = cvt_pk_bf16(v1[2], v1[3]);
                    *(u32x4*)(ob + oo + 2u * (unsigned)(32 * wc + 8 * fq)) = w;
                } else {
                    const f32x4 ca = csa[m], cb = csb[m];
                    const float y10 = v0[0] * ca[0] - v1[0] * ca[1], y20 = v1[0] * ca[0] + v0[0] * ca[1];
                    const float y11 = v0[1] * ca[2] - v1[1] * ca[3], y21 = v1[1] * ca[2] + v0[1] * ca[3];
                    const float y12 = v0[2] * cb[0] - v1[2] * cb[1], y22 = v1[2] * cb[0] + v0[2] * cb[1];
                    const float y13 = v0[3] * cb[2] - v1[3] * cb[3], y23 = v1[3] * cb[2] + v0[3] * cb[3];
                    u32x2 a, b; a.x = cvt_pk_bf16(y10, y11); a.y = cvt_pk_bf16(y12, y13); b.x = cvt_pk_bf16(y20, y21); b.y = cvt_pk_bf16(y22, y23);
                    pair_swap(a, b);
                    const unsigned odd = (unsigned)(fq & 1);
                    if constexpr (TYPE == HT_R64) { const int i0 = 16 * (wc & 1) + 4 * fq; const unsigned d = oo + 2u * (unsigned)(64 * (wc >> 1) + i0) + odd * 56u; *(u32x4*)(ob + d) = (u32x4){a.x, a.y, b.x, b.y}; }
                    else { const int i0 = 16 * wc + 4 * fq;
                        if constexpr (TYPE == HT_RQ) {
                            const unsigned d = (unsigned)row * (unsigned)(DM * 2) + 2u * (unsigned)(128 * ht + i0) + odd * 120u;
                            *(u32x4*)(qb + d) = (u32x4){a.x, a.y, b.x, b.y};
                            u32x2 c, e; c.x = cvt_pk_bf16(v0[0], v0[1]); c.y = cvt_pk_bf16(v0[2], v0[3]); e.x = cvt_pk_bf16(v1[0], v1[1]); e.y = cvt_pk_bf16(v1[2], v1[3]);
                            pair_swap(c, e);
                            *(u32x4*)(ob + oo + 2u * (unsigned)i0 + odd * 120u) = (u32x4){c.x, c.y, e.x, e.y};
                        } else { *(u32x4*)(ob + oo + 2u * (unsigned)i0 + odd * 120u) = (u32x4){a.x, a.y, b.x, b.y}; } }
                }
            }
          asm volatile("" ::: "memory");
        }
    }
    __device__ __forceinline__ void operator()(const f32x4 (&acc)[2][2][4][2], const pg8::Unit& u, int wr, int wc, int fr, int fq) const {
        asm volatile("" : "+v"(fr), "+v"(fq));
#pragma unroll
        for (int bj = 0; bj < 2; ++bj) {
            const int ht = 2 * u.pn + bj, type = ht_type(layer, ht);
            if (type == HT_SKIP) continue;
            if (type == HT_PLAIN) half<HT_PLAIN>(acc, u, bj, ht, wr, wc, fr, fq);
            else if (type == HT_R64) half<HT_R64>(acc, u, bj, ht, wr, wc, fr, fq);
            else if (type == HT_RQ) half<HT_RQ>(acc, u, bj, ht, wr, wc, fr, fq);
            else half<HT_R128>(acc, u, bj, ht, wr, wc, fr, fq);
            asm volatile("" ::: "memory");
        }
    }
};
struct EpiRes {
    const bf16_t* res; bf16_t* out;
    __device__ __forceinline__ void operator()(const f32x4 (&acc)[2][2][4][2], const pg8::Unit& u, int wr, int wc, int fr, int fq) const {
        asm volatile("" : "+v"(fr), "+v"(fq));
        const int row0 = u.pm * 256 + wr * 64 + fr, col0 = u.pn * 256 + wc * 32 + 8 * fq;
        u32x4 q[2][4][2];
#pragma unroll
        for (int ai = 0; ai < 2; ++ai)
#pragma unroll
            for (int m = 0; m < 4; ++m)
#pragma unroll
                for (int bj = 0; bj < 2; ++bj) q[ai][m][bj] = *(const u32x4*)(res + (size_t)(row0 + ai * 128 + m * 16) * DM + col0 + bj * 128);
#pragma unroll
        for (int ai = 0; ai < 2; ++ai)
#pragma unroll
            for (int m = 0; m < 4; ++m) { const size_t off = (size_t)(row0 + ai * 128 + m * 16) * DM + col0;
#pragma unroll
                for (int bj = 0; bj < 2; ++bj) { const u32x4 qq = q[ai][m][bj]; const f32x4 v0 = acc[ai][bj][m][0], v1 = acc[ai][bj][m][1];
                    u32x4 w; w.x = cvt_pk_bf16(bflo(qq.x) * DN_ALPHA + v0[0], bfhi(qq.x) * DN_ALPHA + v0[1]); w.y = cvt_pk_bf16(bflo(qq.y) * DN_ALPHA + v0[2], bfhi(qq.y) * DN_ALPHA + v0[3]);
                    w.z = cvt_pk_bf16(bflo(qq.z) * DN_ALPHA + v1[0], bfhi(qq.z) * DN_ALPHA + v1[1]); w.w = cvt_pk_bf16(bflo(qq.w) * DN_ALPHA + v1[2], bfhi(qq.w) * DN_ALPHA + v1[3]);
                    *(u32x4*)(out + off + bj * 128) = w; } }
    }
};
__device__ __forceinline__ float silu_f(float x) { return x * fast_rcp(1.0f + fast_exp2(-1.44269504089f * x)); }
template <bool F8> struct EpiGU_ {
    bf16_t* H;
    __device__ __forceinline__ void operator()(const f32x4 (&acc)[2][2][4][2], const pg8::Unit& u, int wr, int wc, int fr, int fq) const {
        asm volatile("" : "+v"(fr), "+v"(fq));
#pragma unroll
        for (int ai = 0; ai < 2; ++ai)
#pragma unroll
            for (int m = 0; m < 4; ++m) {
                const size_t row = (size_t)u.gt * 256 + ai * 128 + wr * 64 + m * 16 + fr;
                const f32x4 g0 = acc[ai][0][m][0], g1 = acc[ai][0][m][1], u0 = acc[ai][1][m][0], u1 = acc[ai][1][m][1];
                constexpr float si = F8 ? 1.0f / F8_WSCALE : 1.0f;
                const f32x4 a0 = g0 * si, a1 = g1 * si, b0 = u0 * si, b1 = u1 * si;
                u32x4 w;
                w.x = cvt_pk_bf16(silu_f(a0[0]) * b0[0], silu_f(a0[1]) * b0[1]); w.y = cvt_pk_bf16(silu_f(a0[2]) * b0[2], silu_f(a0[3]) * b0[3]);
                w.z = cvt_pk_bf16(silu_f(a1[0]) * b1[0], silu_f(a1[1]) * b1[1]); w.w = cvt_pk_bf16(silu_f(a1[2]) * b1[2], silu_f(a1[3]) * b1[3]);
                *(u32x4*)(H + row * EDIM + 128 * u.pn + 32 * wc + 8 * fq) = w;
                asm volatile("" ::: "memory");
            }
    }
};
typedef EpiGU_<false> EpiGU; typedef EpiGU_<true> EpiGU8;
template <bool F8> struct EpiDN_ {
    bf16_t* Y;
    __device__ __forceinline__ void operator()(const f32x4 (&acc)[2][2][4][2], const pg8::Unit& u, int wr, int wc, int fr, int fq) const {
        asm volatile("" : "+v"(fr), "+v"(fq));
#pragma unroll
        for (int ai = 0; ai < 2; ++ai)
#pragma unroll
            for (int m = 0; m < 4; ++m) {
                const size_t row = (size_t)u.gt * 256 + ai * 128 + wr * 64 + m * 16 + fr;
                constexpr float sc = (F8 ? 1.0f / (F8_WSCALE * F8_HSCALE) : 1.0f) * F8_YSCALE;
                const f32x4 v0 = acc[ai][0][m][0] * sc, v1 = acc[ai][0][m][1] * sc, v2 = acc[ai][1][m][0] * sc, v3 = acc[ai][1][m][1] * sc;
                u32x4 w; w.x = pk_fp8x4(v0[0], v0[1], v0[2], v0[3]); w.y = pk_fp8x4(v1[0], v1[1], v1[2], v1[3]);
                w.z = pk_fp8x4(v2[0], v2[1], v2[2], v2[3]); w.w = pk_fp8x4(v3[0], v3[1], v3[2], v3[3]);
                *(u32x4*)((unsigned char*)Y + row * DM + 256 * u.pn + 64 * wc + 16 * fq) = w;
            }
    }
};

typedef EpiDN_<false> EpiDN; typedef EpiDN_<true> EpiDN8;

struct Args { const float* in[26]; float* out; unsigned char* ws; int ph_lo, ph_hi; };
struct Frame { LAS unsigned char* lds; unsigned char* ws; unsigned* ctl; int tid, lane, wave, G, bid; };
typedef __attribute__((address_space(4))) const unsigned char* kaptr_t;
__device__ __forceinline__ const float* inp(int i) { kaptr_t ka = (kaptr_t)__builtin_amdgcn_kernarg_segment_ptr(); asm volatile("" : "+s"(ka));
    const unsigned long long v = *(__attribute__((address_space(4))) const unsigned long long*)(ka + 8 * i); return (const float*)(GAS const float*)v; }
__device__ __forceinline__ float* outp_ptr() { kaptr_t ka = (kaptr_t)__builtin_amdgcn_kernarg_segment_ptr(); asm volatile("" : "+s"(ka));
    const unsigned long long v = *(__attribute__((address_space(4))) const unsigned long long*)(ka + 8 * 26); return (float*)(GAS float*)v; }

__device__ __forceinline__ int srccol_id(int R) { return R; }
struct CvtDesc { const float* W; bf16_t* WT; int K, N, NR, kind; };
__device__ __forceinline__ int cvt_col(int kind, int R);
__device__ __forceinline__ void cvt_load(const CvtDesc& d, int it, int lane, f32x4 (&v)[8]) {
    const int nblk = d.NR / 32, kb = it / nblk, nb = it % nblk, k0 = 64 * kb, r0 = 32 * nb, kk8 = lane >> 3, gp = lane & 7;
    const int sc = cvt_col(d.kind, r0 + 4 * gp);
#pragma unroll
    for (int i = 0; i < 8; ++i) v[i] = sc >= 0 ? *(const f32x4*)(d.W + (size_t)(k0 + 8 * i + kk8) * d.N + sc) : (f32x4){0.f, 0.f, 0.f, 0.f};
}
__device__ __forceinline__ void cvt_store(const CvtDesc& d, int it, int lane, const f32x4 (&v)[8], LAS float* scr) {
    const int nblk = d.NR / 32, kb = it / nblk, nb = it % nblk, k0 = 64 * kb, r0 = 32 * nb, kk8 = lane >> 3, gp = lane & 7;
#pragma unroll
    for (int i = 0; i < 8; ++i) { LAS float* p = scr + (8 * i + kk8) * 33 + 4 * gp; p[0] = v[i][0]; p[1] = v[i][1]; p[2] = v[i][2]; p[3] = v[i][3]; }
    LDS_WAIT(); asm volatile("" ::: "memory");
    const int c = lane & 7;
    if (d.kind == 5 || d.kind == 6) {
        const int c4 = lane & 3;
#pragma unroll
        for (int j = 0; j < 2; ++j) { const int n = (lane >> 2) + 16 * j; const LAS float* s = scr + (16 * c4) * 33 + n;
            u32x4 o; o.x = pk_fp8x4(s[0 * 33] * F8_WSCALE, s[1 * 33] * F8_WSCALE, s[2 * 33] * F8_WSCALE, s[3 * 33] * F8_WSCALE); o.y = pk_fp8x4(s[4 * 33] * F8_WSCALE, s[5 * 33] * F8_WSCALE, s[6 * 33] * F8_WSCALE, s[7 * 33] * F8_WSCALE);
            o.z = pk_fp8x4(s[8 * 33] * F8_WSCALE, s[9 * 33] * F8_WSCALE, s[10 * 33] * F8_WSCALE, s[11 * 33] * F8_WSCALE); o.w = pk_fp8x4(s[12 * 33] * F8_WSCALE, s[13 * 33] * F8_WSCALE, s[14 * 33] * F8_WSCALE, s[15 * 33] * F8_WSCALE);
            *(u32x4*)((unsigned char*)d.WT + (size_t)(r0 + n) * d.K + k0 + 16 * c4) = o; }
    } else {
#pragma unroll
    for (int j = 0; j < 4; ++j) { const int n = (lane >> 3) + 8 * j; const LAS float* s = scr + (8 * c) * 33 + n;
        u32x4 o; o.x = cvt_pk_bf16(s[0 * 33], s[1 * 33]); o.y = cvt_pk_bf16(s[2 * 33], s[3 * 33]); o.z = cvt_pk_bf16(s[4 * 33], s[5 * 33]); o.w = cvt_pk_bf16(s[6 * 33], s[7 * 33]);
        if (d.kind == 8) {
            const int k8 = (k0 >> 3) + c, rn = r0 + n; *(u32x4*)(d.WT + ((((size_t)(rn >> 5) * 256 + (k8 >> 1)) * 64 + (k8 & 1) * 32 + (rn & 31)) << 3)) = o; }
        else *(u32x4*)(d.WT + (size_t)(r0 + n) * d.K + k0 + 8 * c) = o; }
    }
    LDS_WAIT(); asm volatile("" ::: "memory");
}
struct ColIn0 { __device__ __forceinline__ int operator()(int R) const { const int ht = R >> 7; return 128 * ht + map_col(ht_map(ht_type(0, ht)), R & 127); } };
struct ColIn1 { __device__ __forceinline__ int operator()(int R) const { const int ht = R >> 7; const int c = 128 * ht + map_col(ht_map(ht_type(1, ht)), R & 127); return c < N1R ? c : -1; } };
struct ColId  { __device__ __forceinline__ int operator()(int R) const { return R; } };
struct ColGU  { __device__ __forceinline__ int operator()(int R) const { return 512 * ((R >> 7) & 1) + 128 * (R >> 8) + map_col(MAP_PLAIN, R & 127); } };
struct ColDN  { __device__ __forceinline__ int operator()(int R) const { return (R & ~127) + map_col(MAP_PLAIN, R & 127); } };
struct ColDN2 { __device__ __forceinline__ int operator()(int R) const { const int inner = map_col(MAP_PLAIN, R & 127), bj = (R >> 7) & 1; return (R & ~255) + 64 * (inner >> 5) + 16 * ((inner >> 3) & 3) + 8 * bj + (inner & 7); } };

namespace cvi {
constexpr int I_AIN = 32 * (N0 / 32), I_SQ = 32 * (DM / 32), I_CIN = 32 * (N1 / 32), I_W1 = 64 * 4, I_W2 = 2 * 4, I_RT = 32 * 2, I_GU = 32 * 32, I_DN = 8 * 64;
constexpr int O1 = I_AIN, O2 = O1 + I_SQ, O3 = O2 + I_CIN, O4 = O3 + I_SQ, O5 = O4 + 2 * I_W1, O6 = O5 + 2 * I_W2, O7 = O6 + 2 * I_RT, O8 = O7 + 130 * I_GU, O9 = O8 + 130 * I_DN;
}
__device__ __forceinline__ void cvt_pipeline(const Frame& F, const Args& A, int cb, int cG, int mb_lo, int mb_hi, int sm_lo, int sm_hi, int sm_w0, int sm_st) {
    using namespace cvi;
    unsigned char* ws = F.ws; const int ln = fresh_lane();
    LAS float* scr = (LAS float*)(F.lds + F.wave * 16384);
    auto desc_of = [&](int it, int& li) -> CvtDesc {
        CvtDesc d;
        if (it >= O7) {
            if (it < O8) { const int r = it - O7, mi = r / I_GU, layer = mi / 65, e = mi % 65; li = r % I_GU;
                d.W = e < NEXP ? inp(22) + ((size_t)layer * NEXP + e) * DM * 1024 : inp(24) + (size_t)layer * DM * 1024;
                d.WT = (bf16_t*)(ws + WS_WGU + (size_t)layer * 65 * WGU_E + (size_t)e * (WGU_E / 2)); d.K = DM; d.N = 1024; d.NR = 1024; d.kind = 5; }
            else { const int r = it - O8, mi = r / I_DN, layer = mi / 65, e = mi % 65; li = r % I_DN;
                d.W = e < NEXP ? inp(23) + ((size_t)layer * NEXP + e) * EDIM * DM : inp(25) + (size_t)layer * EDIM * DM;
                d.WT = (bf16_t*)(ws + WS_WDN + (size_t)mi * WDN_E); d.K = EDIM; d.N = DM; d.NR = DM; d.kind = 7; }
        }
        else if (it < O1) { li = it; d.W = inp(1); d.WT = (bf16_t*)(ws + WS_WAIN); d.K = DM; d.N = N0; d.NR = N0; d.kind = 1; }
        else if (it < O2) { li = it - O1; d.W = inp(7); d.WT = (bf16_t*)(ws + WS_WAOUT); d.K = DM; d.N = DM; d.NR = DM; d.kind = 4; }
        else if (it < O3) { li = it - O2; d.W = inp(8); d.WT = (bf16_t*)(ws + WS_WCIN); d.K = DM; d.N = N1R; d.NR = N1; d.kind = 2; }
        else if (it < O4) { li = it - O3; d.W = inp(15); d.WT = (bf16_t*)(ws + WS_WCOUT); d.K = DM; d.N = DM; d.NR = DM; d.kind = 4; }
        else if (it < O5) { const int r = it - O4, kv = r / I_W1; li = r % I_W1; d.W = inp(kv ? 13 : 10); d.WT = (bf16_t*)(ws + (kv ? WS_W1VT : WS_W1KT)); d.K = 4096; d.N = 128; d.NR = 128; d.kind = 8; }
        else if (it < O6) { const int r = it - O5, kv = r / I_W2; li = r % I_W2; d.W = inp(kv ? 14 : 11); d.WT = (bf16_t*)(ws + (kv ? WS_W2VT : WS_W2KT)); d.K = 128; d.N = 128; d.NR = 128; d.kind = 0; }
        else { const int r = it - O6, layer = r / I_RT; li = r % I_RT; d.W = inp(20) + (size_t)layer * DM * 64; d.WT = (bf16_t*)(ws + WS_WRT + (size_t)layer * 64 * DM * 2); d.K = DM; d.N = 64; d.NR = 64; d.kind = 0; }
        return d;
    };
    constexpr int NMB_GU = 130 * 32;
    const int nq_exp = (cb >= 0 && mb_lo + cb < mb_hi) ? 4 * ((mb_hi - 1 - mb_lo - cb) / cG + 1) : 0;
    auto item_of = [&](int q) -> int {
        if (q < nq_exp) { const int mb = mb_lo + cb + cG * (q >> 2), kbl = q & 3, nbl = F.wave;
            if (mb < NMB_GU) { const int mi = mb >> 5, r = mb & 31; return O7 + mi * I_GU + (4 * (r >> 2) + kbl) * 32 + 8 * (r & 3) + nbl; }
            const int m2 = mb - NMB_GU, mi = m2 >> 4, r = m2 & 15; return O8 + mi * I_DN + (4 * (r >> 3) + kbl) * 64 + 8 * (r & 7) + nbl; }
        const int it = sm_lo + sm_w0 + sm_st * (q - nq_exp); return it < sm_hi ? it : -1;
    };
    { int q = 0; int id0 = item_of(0);
      if (id0 >= 0) {
        int l0, l1 = 0, l2 = 0; CvtDesc d0 = desc_of(id0, l0), d1 = d0, d2 = d0; f32x4 v0[8], v1[8], v2[8];
        cvt_load(d0, l0, ln, v0);
        int id1 = item_of(1); if (id1 >= 0) { d1 = desc_of(id1, l1); cvt_load(d1, l1, ln, v1); }
        for (;;) {
            const int id2 = id1 >= 0 ? item_of(q + 2) : -1;
            if (id2 >= 0) { d2 = desc_of(id2, l2); cvt_load(d2, l2, ln, v2); }
            cvt_store(d0, l0, ln, v0, scr);
            if (id1 < 0) break;
            d0 = d1; l0 = l1; d1 = d2; l1 = l2; id1 = id2; ++q;
#pragma unroll
            for (int i = 0; i < 8; ++i) { v0[i] = v1[i]; v1[i] = v2[i]; }
        }
      } }
}
constexpr int NCONV = 64, NMB_ALL = 130 * 32 + 130 * 16, CVT_CH = 1;
__device__ __forceinline__ void cvt_dynamic(const Frame& F, const Args& A, int phase_idx, int nworkers, bool is_worker, bool drain) {
    unsigned* qn = F.ctl + CW_QNEXT; unsigned* done = F.ctl + CW_DONE + 64 * phase_idx;
    LAS int* slot = (LAS int*)(F.lds + MISC_OFF + MO_GEN); const int tid = F.wave * 64 + fresh_lane();
    __syncthreads();
    if (is_worker && !drain && tid == 0) __hip_atomic_fetch_add(done, 1u, __ATOMIC_RELAXED, __HIP_MEMORY_SCOPE_AGENT);
    constexpr int NSM = (cvi::O6 - cvi::O2 + 63) / 64, NCH = NSM + (NMB_ALL + CVT_CH - 1) / CVT_CH;
    for (;;) {
        if (tid == 0) { int c = -1;
            const bool go = drain || __hip_atomic_load(done, __ATOMIC_RELAXED, __HIP_MEMORY_SCOPE_AGENT) < (unsigned)nworkers;
            if (go) { c = (int)__hip_atomic_fetch_add(qn, 1u, __ATOMIC_RELAXED, __HIP_MEMORY_SCOPE_AGENT); if (c >= NCH) c = -1; }
            *slot = c; }
        __syncthreads();
        const int c = __builtin_amdgcn_readfirstlane(*slot);
        __syncthreads();
        if (c < 0) break;
        if (c < NSM) { const int lo = cvi::O2 + 64 * c, hi = lo + 64 < cvi::O6 ? lo + 64 : cvi::O6; cvt_pipeline(F, A, -1, 1, 0, 0, lo, hi, F.wave, 8); }
        else { const int lo = (c - NSM) * CVT_CH, hi = lo + CVT_CH < NMB_ALL ? lo + CVT_CH : NMB_ALL; cvt_pipeline(F, A, 0, 1, lo, hi, 0, 0, 0, 1); }
    }
}
__device__ __forceinline__ void p0_prologue(const Frame& F, const Args& A) {
    unsigned char* ws = F.ws;
    cvt_pipeline(F, A, -1, 1, 0, 0, 0, cvi::O1, F.bid * 8 + F.wave, F.G * 8);
    { const float* x = inp(0); bf16_t* xb = (bf16_t*)(ws + WS_XB);
      const size_t NP = (size_t)T * DM / 8, st = (size_t)F.G * 512;
      size_t i = (size_t)F.bid * 512 + F.tid;
      for (; i + 3 * st < NP; i += 4 * st) {
          f32x4 a[4], b[4];
#pragma unroll
          for (int u = 0; u < 4; ++u) { a[u] = *(const f32x4*)(x + (i + u * st) * 8); b[u] = *(const f32x4*)(x + (i + u * st) * 8 + 4); }
#pragma unroll
          for (int u = 0; u < 4; ++u) { u32x4 w; w.x = cvt_pk_bf16(a[u][0], a[u][1]); w.y = cvt_pk_bf16(a[u][2], a[u][3]); w.z = cvt_pk_bf16(b[u][0], b[u][1]); w.w = cvt_pk_bf16(b[u][2], b[u][3]);
              *(u32x4*)(xb + (i + u * st) * 8) = w; } }
      for (; i < NP; i += st) {
          const f32x4 a = *(const f32x4*)(x + i * 8), b = *(const f32x4*)(x + i * 8 + 4);
          u32x4 w; w.x = cvt_pk_bf16(a[0], a[1]); w.y = cvt_pk_bf16(a[2], a[3]); w.z = cvt_pk_bf16(b[0], b[1]); w.w = cvt_pk_bf16(b[2], b[3]);
          *(u32x4*)(xb + i * 8) = w; } }
    { f32x2* r128 = (f32x2*)(ws + WS_ROPE128); f32x2* r64 = (f32x2*)(ws + WS_ROPE64);
      for (int i = F.bid * 512 + F.tid; i < SEQ * 96; i += F.G * 512) {
          int pos, idx; float inv; f32x2* dst;
          if (i < SEQ * 64) { pos = i >> 6; idx = i & 63; inv = powf(10000.0f, -(float)idx * 2.0f / 128.0f); dst = r128 + i; }
          else { const int j = i - SEQ * 64; pos = j >> 5; idx = j & 31; inv = powf(10000.0f, -(float)idx * 2.0f / 64.0f); dst = r64 + j; }
          const float ang = (float)pos * inv;
          const double rev = (double)ang * 0.15915494309189533577; const double fr = rev - __builtin_rint(rev); const float f = (float)fr;
          f32x2 cs; cs.x = __builtin_amdgcn_cosf(f); cs.y = __builtin_amdgcn_sinf(f); *dst = cs; } }
}
__device__ __forceinline__ void pe_bias(const Frame& F, const Args& A) {
    unsigned char* ws = F.ws; const int tid = F.wave * 64 + fresh_lane();
    if (F.bid >= F.G - 2) {
        const int kv = F.G - 1 - F.bid; const float* pe = inp(kv ? 12 : 9); const float* w1 = inp(kv ? 13 : 10);
        const int jq = tid & 31, part = tid >> 5; f32x4 s = {0.f, 0.f, 0.f, 0.f};
#pragma unroll 16
        for (int k = part * 256; k < part * 256 + 256; ++k) s += *(const f32x4*)(w1 + (size_t)k * 128 + 4 * jq) * pe[k];
        LAS f32x4* red = (LAS f32x4*)(F.lds + MISC_OFF + MO_GEN);
        __syncthreads();
        red[tid] = s; __syncthreads();
        if (tid < 32) { f32x4 t = red[tid];
#pragma unroll
            for (int pp = 1; pp < 16; ++pp) t += red[tid + 32 * pp];
            *(f32x4*)((float*)(ws + WS_PEB) + kv * 128 + 4 * tid) = t; }
        __syncthreads();
    }
}

__device__ __forceinline__ int cvt_col(int kind, int R) {
    if (kind == 1) return ColIn0()(R);
    if (kind == 2) return ColIn1()(R);
    if (kind == 3 || kind == 5) return ColGU()(R);
    if (kind == 4 || kind == 6) return ColDN()(R);
    if (kind == 7) return ColDN2()(R);
    return R;
}

struct RowLN { f32x4 v[8]; float mean, rstd; };
__device__ __forceinline__ void ln_load_stats(RowLN& r, const float* y, int lane) {
    float s = 0.f;
#pragma unroll
    for (int j = 0; j < 4; ++j) { const float* p = y + 8 * (64 * j + lane); r.v[2 * j] = *(const f32x4*)p; r.v[2 * j + 1] = *(const f32x4*)(p + 4);
        s += (r.v[2 * j][0] + r.v[2 * j][1]) + (r.v[2 * j][2] + r.v[2 * j][3]) + (r.v[2 * j + 1][0] + r.v[2 * j + 1][1]) + (r.v[2 * j + 1][2] + r.v[2 * j + 1][3]); }
    r.mean = wave_sum(s) * (1.0f / DM); float q = 0.f;
#pragma unroll
    for (int i = 0; i < 8; ++i) { const f32x4 d = r.v[i] - r.mean; q += (d[0] * d[0] + d[1] * d[1]) + (d[2] * d[2] + d[3] * d[3]); }
    r.rstd = 1.0f / sqrtf(wave_sum(q) * (1.0f / DM) + LN_EPS);
}
__device__ __forceinline__ void row_load_bf16(RowLN& r, const bf16_t* y, int lane) {
#pragma unroll
    for (int j = 0; j < 4; ++j) { const u32x4 q = *(const u32x4*)(y + 8 * (64 * j + lane));
        r.v[2 * j] = (f32x4){bflo(q.x), bfhi(q.x), bflo(q.y), bfhi(q.y)}; r.v[2 * j + 1] = (f32x4){bflo(q.z), bfhi(q.z), bflo(q.w), bfhi(q.w)}; }
}
__device__ __forceinline__ void ln_stats_only(RowLN& r) {
    float s = 0.f;
#pragma unroll
    for (int i = 0; i < 8; ++i) s += (r.v[i][0] + r.v[i][1]) + (r.v[i][2] + r.v[i][3]);
    r.mean = wave_sum(s) * (1.0f / DM); float q = 0.f;
#pragma unroll
    for (int i = 0; i < 8; ++i) { const f32x4 d = r.v[i] - r.mean; q += (d[0] * d[0] + d[1] * d[1]) + (d[2] * d[2] + d[3] * d[3]); }
    r.rstd = 1.0f / sqrtf(wave_sum(q) * (1.0f / DM) + LN_EPS);
}
__device__ __forceinline__ void ln_apply(RowLN& r, const float* g, const float* b, int lane) {
#pragma unroll
    for (int j = 0; j < 4; ++j) { const int c = 8 * (64 * j + lane);
        const f32x4 g0 = *(const f32x4*)(g + c), g1 = *(const f32x4*)(g + c + 4), b0 = *(const f32x4*)(b + c), b1 = *(const f32x4*)(b + c + 4);
        r.v[2 * j] = (r.v[2 * j] - r.mean) * r.rstd * g0 + b0; r.v[2 * j + 1] = (r.v[2 * j + 1] - r.mean) * r.rstd * g1 + b1; }
}
__device__ __forceinline__ void ln_apply_lds(RowLN& r, const LAS float* g, const LAS float* b, int lane) {
#pragma unroll
    for (int j = 0; j < 4; ++j) { const int c = 8 * (64 * j + lane);
        const f32x4 g0 = *(const LAS f32x4*)(g + c), g1 = *(const LAS f32x4*)(g + c + 4), b0 = *(const LAS f32x4*)(b + c), b1 = *(const LAS f32x4*)(b + c + 4);
        r.v[2 * j] = (r.v[2 * j] - r.mean) * r.rstd * g0 + b0; r.v[2 * j + 1] = (r.v[2 * j + 1] - r.mean) * r.rstd * g1 + b1; }
}
__device__ __forceinline__ void row_store_bf16(const RowLN& r, bf16_t* o, int lane) {
#pragma unroll
    for (int j = 0; j < 4; ++j) { u32x4 w; w.x = cvt_pk_bf16(r.v[2 * j][0], r.v[2 * j][1]); w.y = cvt_pk_bf16(r.v[2 * j][2], r.v[2 * j][3]); w.z = cvt_pk_bf16(r.v[2 * j + 1][0], r.v[2 * j + 1][1]); w.w = cvt_pk_bf16(r.v[2 * j + 1][2], r.v[2 * j + 1][3]);
        *(u32x4*)(o + 8 * (64 * j + lane)) = w; }
}

__device__ __forceinline__ void phase_ln_router(const Frame& F, const Args& A, int layer) {
    unsigned char* ws = F.ws;
    const bf16_t* y1 = (const bf16_t*)(ws + WS_Y1); bf16_t* hb = (bf16_t*)(ws + WS_HB); float* stats = (float*)(ws + WS_STATS);
    const float* g = inp(16) + (size_t)layer * DM; const float* b = inp(17) + (size_t)layer * DM;
    const bf16_t* wrt = (const bf16_t*)(ws + WS_WRT + (size_t)layer * 64 * DM * 2);
    const float* rbias = inp(21) + (size_t)layer * NEXP;
    unsigned* gcnt = F.ctl + CW_CNT + layer * 64 * 64;
    int* toke = (int*)(ws + WS_TOKE); int* tokp = (int*)(ws + WS_TOKP); float* tokw = (float*)(ws + WS_TOKW); int* list = (int*)(ws + WS_LIST);
    LAS float* lg = (LAS float*)F.lds; LAS float* bs = lg + 64 * 65;
    LAS int* sel_e = (LAS int*)(bs + 64 * 65); LAS int* sel_lp = sel_e + 512; LAS float* sel_w = (LAS float*)(sel_lp + 512);
    LAS int* lcnt = (LAS int*)(sel_w + 512); LAS int* gbase = lcnt + 64;
    LAS float* pl = (LAS float*)(F.lds + 65536);
    __syncthreads();
    { const f32x4 a = *(const f32x4*)(g + 4 * F.tid), c = *(const f32x4*)(b + 4 * F.tid); *(LAS f32x4*)(pl + 4 * F.tid) = a; *(LAS f32x4*)(pl + 2048 + 4 * F.tid) = c; }
    __syncthreads();
    for (int blk = F.bid; blk < T / 64; blk += F.G) {
        const int row0 = blk * 64;
        if (F.tid < 64) lcnt[F.tid] = 0;
        { RowLN rn;
          row_load_bf16(rn, y1 + (size_t)(row0 + F.wave * 8) * DM, F.lane);
          for (int i = 0; i < 8; ++i) { const int row = row0 + F.wave * 8 + i; RowLN r = rn;
            if (i < 7) row_load_bf16(rn, y1 + (size_t)(row + 1) * DM, F.lane);
            ln_stats_only(r);
            if (F.lane == 0) { stats[2 * row] = r.mean; stats[2 * row + 1] = r.rstd; }
            ln_apply_lds(r, pl, pl + 2048, F.lane); row_store_bf16(r, hb + (size_t)row * DM, F.lane);
            { unsigned char* h8 = ws + WS_HB8 + (size_t)row * DM;
#pragma unroll
                for (int j = 0; j < 4; ++j) { u32x2 w; w.x = pk_fp8x4(r.v[2 * j][0], r.v[2 * j][1], r.v[2 * j][2], r.v[2 * j][3]); w.y = pk_fp8x4(r.v[2 * j + 1][0], r.v[2 * j + 1][1], r.v[2 * j + 1][2], r.v[2 * j + 1][3]); *(u32x2*)(h8 + 8 * (64 * j + F.lane)) = w; } } } }
        wg_self_visible(F.wave);
        { const int kh = F.wave & 1, tb2 = F.wave >> 1, rb2 = tb2 >> 1, eb = tb2 & 1, fr = F.lane & 15, kq = F.lane >> 4;
          const bf16_t* ap0 = hb + (size_t)(row0 + 32 * rb2 + fr) * DM + 8 * kq + 1024 * kh; const bf16_t* ap1 = ap0 + (size_t)16 * DM;
          const bf16_t* bp0 = wrt + (size_t)(32 * eb + fr) * DM + 8 * kq + 1024 * kh; const bf16_t* bp1 = bp0 + (size_t)16 * DM;
          f32x4 c00 = {0.f, 0.f, 0.f, 0.f}, c01 = c00, c10 = c00, c11 = c00;
#pragma unroll 8
          for (int ks = 0; ks < DM / 64; ++ks) { const bf16x8 a0 = *(const bf16x8*)(ap0 + 32 * ks), a1 = *(const bf16x8*)(ap1 + 32 * ks), b0 = *(const bf16x8*)(bp0 + 32 * ks), b1 = *(const bf16x8*)(bp1 + 32 * ks);
              c00 = __builtin_amdgcn_mfma_f32_16x16x32_bf16(a0, b0, c00, 0, 0, 0); c01 = __builtin_amdgcn_mfma_f32_16x16x32_bf16(a0, b1, c01, 0, 0, 0);
              c10 = __builtin_amdgcn_mfma_f32_16x16x32_bf16(a1, b0, c10, 0, 0, 0); c11 = __builtin_amdgcn_mfma_f32_16x16x32_bf16(a1, b1, c11, 0, 0, 0); }
          LAS float* lo_ = kh ? bs : lg;
#pragma unroll
          for (int rg = 0; rg < 4; ++rg) { const int r = 32 * rb2 + 4 * kq + rg;
              lo_[r * 65 + 32 * eb + fr] = c00[rg]; lo_[r * 65 + 32 * eb + 16 + fr] = c01[rg]; lo_[(r + 16) * 65 + 32 * eb + fr] = c10[rg]; lo_[(r + 16) * 65 + 32 * eb + 16 + fr] = c11[rg]; } }
        __syncthreads();
        { const int e = F.lane, grp = e >> 3; const float rb = rbias[e];
          for (int i = 0; i < 8; ++i) { const int r = 8 * F.wave + i;
            const float sc = 1.0f / (1.0f + __expf(-(lg[r * 65 + e] + bs[r * 65 + e]))), v = sc + rb;
            float m1 = v; m1 = fmaxf(m1, swz_xor<1>(m1)); m1 = fmaxf(m1, swz_xor<2>(m1)); m1 = fmaxf(m1, swz_xor<4>(m1));
            const unsigned long long eq = __ballot(v == m1) >> (8 * grp); const int first = __builtin_ctzll(eq | 0x100ull);
            float v2 = ((e & 7) == first) ? -3e38f : v; v2 = fmaxf(v2, swz_xor<1>(v2)); v2 = fmaxf(v2, swz_xor<2>(v2)); v2 = fmaxf(v2, swz_xor<4>(v2));
            const float gs = m1 + v2;
            int grank = 0;
#pragma unroll
            for (int gq = 0; gq < 8; ++gq) { const float o = __int_as_float(__builtin_amdgcn_readlane(__float_as_int(gs), 8 * gq)); grank += (o > gs || (o == gs && gq < grp)) ? 1 : 0; }
            const float vc = grank < TOPKG ? v : NEGF;
            int rank = 0;
#pragma unroll
            for (int q = 0; q < 64; ++q) { const float o = __int_as_float(__builtin_amdgcn_readlane(__float_as_int(vc), q)); rank += (o > vc || (o == vc && q < e)) ? 1 : 0; }
            const bool pick = rank < TOPK;
            const float wsum = wave_sum(pick ? sc : 0.f);
            if (pick) { sel_e[r * 8 + rank] = e; sel_w[r * 8 + rank] = sc * (2.5f / wsum); sel_lp[r * 8 + rank] = __hip_atomic_fetch_add(&lcnt[e], 1, __ATOMIC_RELAXED, __HIP_MEMORY_SCOPE_WORKGROUP); } } }
        __syncthreads();
        if (F.tid < 64) { const int n = lcnt[F.tid]; gbase[F.tid] = n > 0 ? (int)atomicAdd(&gcnt[F.tid * 64], (unsigned)n) : 0; }
        __syncthreads();
        { const int r = F.tid >> 3, k = F.tid & 7, tok = row0 + r, e = sel_e[r * 8 + k], pos = gbase[e] + sel_lp[r * 8 + k];
          toke[tok * 8 + k] = e; tokp[tok * 8 + k] = pos; tokw[tok * 8 + k] = sel_w[r * 8 + k]; list[(size_t)e * T + pos] = tok; }
        __syncthreads();
    }
}

__device__ __forceinline__ MoeTabs build_moe_tabs(const Frame& F, int layer) {
    LAS int* tpre = (LAS int*)(F.lds + MISC_OFF + MO_TPRE); LAS int* cnt = (LAS int*)(F.lds + MISC_OFF + MO_CNT); LAS unsigned char* etab = (LAS unsigned char*)(F.lds + MISC_OFF + MO_ETAB);
    const unsigned* gcnt = F.ctl + CW_CNT + layer * 64 * 64;
    __syncthreads();
    if (F.tid < 64) cnt[F.tid] = (int)__hip_atomic_load(gcnt + F.tid * 64, __ATOMIC_RELAXED, __HIP_MEMORY_SCOPE_AGENT);
    if (F.tid == 64) cnt[64] = T;
    __syncthreads();
    if (F.tid <= NEXP + 1) { int s = 0; for (int e = 0; e < F.tid; ++e) s += (cnt[e] + 255) >> 8; tpre[F.tid] = s; }
    __syncthreads();
    if (F.tid < NEXP) { const int hi = tpre[F.tid + 1]; for (int t = tpre[F.tid]; t < hi; ++t) etab[t] = (unsigned char)F.tid; }
    else if (F.tid < NEXP + 64) { const int t = tpre[NEXP] + (F.tid - NEXP); if (t < tpre[NEXP + 1]) etab[t] = (unsigned char)NEXP; }
    __syncthreads();
    MoeTabs tb; tb.tpre = tpre; tb.cnt = cnt; tb.etab = etab; tb.ntiles = __builtin_amdgcn_readfirstlane(tpre[65]); return tb;
}

__device__ __forceinline__ void phase_combine_ln(const Frame& F, const Args& A, int layer, const MoeTabs& tb) {
    unsigned char* ws = F.ws;
    const bf16_t* y1 = (const bf16_t*)(ws + WS_Y1); const float* stats = (const float*)(ws + WS_STATS);
    const float* g1 = inp(16) + (size_t)layer * DM; const float* b1 = inp(17) + (size_t)layer * DM;
    const float* g2 = inp(18) + (size_t)layer * DM; const float* b2 = inp(19) + (size_t)layer * DM;
    const int* toke = (const int*)(ws + WS_TOKE); const int* tokp = (const int*)(ws + WS_TOKP); const float* tokw = (const float*)(ws + WS_TOKW);
    const unsigned char* Y = (const unsigned char*)(ws + WS_YBUF);
    float* outf = outp_ptr(); bf16_t* xb = (bf16_t*)(ws + WS_XB);
    const int gw = F.bid * 8 + F.wave, NGW = F.G * 8;
    const int shared0 = __builtin_amdgcn_readfirstlane(tb.tpre[NEXP]) * 256;
    LAS float* pl = (LAS float*)F.lds;
    __syncthreads();
    { const f32x4 a = *(const f32x4*)(g1 + 4 * F.tid), b = *(const f32x4*)(b1 + 4 * F.tid), c = *(const f32x4*)(g2 + 4 * F.tid), d = *(const f32x4*)(b2 + 4 * F.tid);
      *(LAS f32x4*)(pl + 4 * F.tid) = a; *(LAS f32x4*)(pl + 2048 + 4 * F.tid) = b; *(LAS f32x4*)(pl + 4096 + 4 * F.tid) = c; *(LAS f32x4*)(pl + 6144 + 4 * F.tid) = d; }
    __syncthreads();
    for (int row = gw; row < T; row += NGW) {
        RowLN r;
        row_load_bf16(r, y1 + (size_t)row * DM, F.lane);
        r.mean = stats[2 * row]; r.rstd = stats[2 * row + 1];
        ln_apply_lds(r, pl, pl + 2048, F.lane);
#pragma unroll
        for (int i = 0; i < 8; ++i) r.v[i] = r.v[i] * DN_ALPHA;
        size_t srow[TOPK + 1]; float sw[TOPK + 1];
#pragma unroll
        for (int k = 0; k < TOPK; ++k) { const int e = toke[row * 8 + k]; srow[k] = (size_t)tb.tpre[e] * 256 + tokp[row * 8 + k]; sw[k] = tokw[row * 8 + k]; }
        srow[TOPK] = (size_t)shared0 + row; sw[TOPK] = 1.0f;
        u32x2 yq[TOPK + 1][4];
#pragma unroll
        for (int k = 0; k <= TOPK; ++k)
#pragma unroll
            for (int j = 0; j < 4; ++j) yq[k][j] = *(const u32x2*)(Y + srow[k] * DM + 8 * (64 * j + F.lane));
#pragma unroll
        for (int k = 0; k <= TOPK; ++k) { const float w = sw[k] * (1.0f / F8_YSCALE);
#pragma unroll
            for (int j = 0; j < 4; ++j) { const u32x2 q = yq[k][j];
                const f32x2 a = __builtin_amdgcn_cvt_pk_f32_fp8((int)q.x, false), b = __builtin_amdgcn_cvt_pk_f32_fp8((int)q.x, true), c = __builtin_amdgcn_cvt_pk_f32_fp8((int)q.y, false), d = __builtin_amdgcn_cvt_pk_f32_fp8((int)q.y, true);
                r.v[2 * j][0] += w * a[0]; r.v[2 * j][1] += w * a[1]; r.v[2 * j][2] += w * b[0]; r.v[2 * j][3] += w * b[1];
                r.v[2 * j + 1][0] += w * c[0]; r.v[2 * j + 1][1] += w * c[1]; r.v[2 * j + 1][2] += w * d[0]; r.v[2 * j + 1][3] += w * d[1]; } }
        float s = 0.f;
#pragma unroll
        for (int i = 0; i < 8; ++i) s += (r.v[i][0] + r.v[i][1]) + (r.v[i][2] + r.v[i][3]);
        r.mean = wave_sum(s) * (1.0f / DM); float q = 0.f;
#pragma unroll
        for (int i = 0; i < 8; ++i) { const f32x4 d = r.v[i] - r.mean; q += (d[0] * d[0] + d[1] * d[1]) + (d[2] * d[2] + d[3] * d[3]); }
        r.rstd = 1.0f / sqrtf(wave_sum(q) * (1.0f / DM) + LN_EPS);
        ln_apply_lds(r, pl + 4096, pl + 6144, F.lane);
        if (layer == 0) row_store_bf16(r, xb + (size_t)row * DM, F.lane);
        else {
#pragma unroll
            for (int j = 0; j < 4; ++j) { float* p = outf + (size_t)row * DM + 8 * (64 * j + F.lane); *(f32x4*)p = r.v[2 * j]; *(f32x4*)(p + 4) = r.v[2 * j + 1]; } }
    }
}

__device__ __forceinline__ unsigned offb(unsigned row, unsigned ch) { return 256u * row + 16u * (ch ^ (((row & 3u) << 2) | ((row >> 2) & 3u))); }
__device__ __forceinline__ int crow(int r, int hi) { return (r & 3) + 8 * (r >> 2) + 4 * hi; }
#define MFMA32(a, b, c) __builtin_amdgcn_mfma_f32_32x32x16_bf16((a), (b), (c), 0, 0, 0)

struct KVRegs { u32x4 k0, k1, v0, v1; };
__device__ __forceinline__ void kv_gload(KVRegs& s, const bf16_t* K, const bf16_t* V, int ldk, int ldv, int key0, int tid) {
    const int r = tid >> 4, c = (tid & 15) * 8;
    s.k0 = *(const u32x4*)(K + (size_t)(key0 + r) * ldk + c); s.k1 = *(const u32x4*)(K + (size_t)(key0 + 32 + r) * ldk + c);
    s.v0 = *(const u32x4*)(V + (size_t)(key0 + r) * ldv + c); s.v1 = *(const u32x4*)(V + (size_t)(key0 + 32 + r) * ldv + c);
}
__device__ __forceinline__ void kv_lwrite(const KVRegs& s, LAS unsigned char* Kb, LAS unsigned char* Vb, int tid) {
    const unsigned o = offb(tid >> 4, tid & 15);
    *(LAS u32x4*)(Kb + o) = s.k0; *(LAS u32x4*)(Kb + o + 8192) = s.k1; *(LAS u32x4*)(Vb + o) = s.v0; *(LAS u32x4*)(Vb + o + 8192) = s.v1;
}
struct LaneGeo { int r, h, krow, kx; unsigned va0, va1, q; };
__device__ __forceinline__ LaneGeo lane_geo(int lane) {
    LaneGeo g; g.r = lane & 31; g.h = lane >> 5; g.krow = 256 * g.r; g.kx = ((g.r & 3) << 2) | ((g.r >> 2) & 3);
    const int blk = (lane >> 4) & 1, q = (lane & 15) >> 2, p = lane & 3;
    g.q = q;
    g.va0 = 256u * (4 * g.h + q) + 16u * ((2 * blk + (p >> 1)) ^ g.h) + 8u * (p & 1);
    g.va1 = 256u * (8 + 4 * g.h + q) + 16u * ((2 * blk + (p >> 1)) ^ (2 + g.h)) + 8u * (p & 1);
    return g;
}
template <int OFF> __device__ __forceinline__ s16x4 tr_read(unsigned a) { s16x4 r; asm volatile("ds_read_b64_tr_b16 %0, %1 offset:%2" : "=&v"(r) : "v"(a), "i"(OFF) : "memory"); return r; }
template <int N> __device__ __forceinline__ void lgk_wait() { asm volatile("s_waitcnt lgkmcnt(%0)" :: "i"(N) : "memory"); SBAR(); }
template <int N> __device__ __forceinline__ void lgk_wait_k(bf16x8& a) { asm volatile("s_waitcnt lgkmcnt(%1)" : "+v"(a) : "i"(N) : "memory"); SBAR(); }
template <int N> __device__ __forceinline__ void lgk_wait_v(s16x4& a, s16x4& b) { asm volatile("s_waitcnt lgkmcnt(%2)" : "+v"(a), "+v"(b) : "i"(N) : "memory"); SBAR(); }
#define PKV(L, H) (bf16x8){L[0], L[1], L[2], L[3], H[0], H[1], H[2], H[3]}
template <int I> __device__ __forceinline__ void v_issue(s16x4 (&vl)[16], s16x4 (&vh)[16], unsigned v0a, unsigned v1a, unsigned q) {
    constexpr int c = I >> 2, kk = I & 3; const unsigned o = 64u * ((unsigned)c ^ q);
    vl[I] = tr_read<4096 * kk>(v0a + o); vh[I] = tr_read<4096 * kk>(v1a + o);
}
template <int I> struct PVStep {
    static __device__ __forceinline__ void run(s16x4 (&vl)[16], s16x4 (&vh)[16], unsigned v0a, unsigned v1a, unsigned q, const bf16x8 (&pf)[4], f32x16 (&O)[4]) {
        constexpr int LEFT = 15 - I, W = LEFT < 7 ? 2 * LEFT : 14;
        lgk_wait_v<W>(vl[I], vh[I]);
        O[I >> 2] = MFMA32(PKV(vl[I], vh[I]), pf[I & 3], O[I >> 2]);
        SBAR();
        if constexpr (I + 8 < 16) { v_issue<I + 8>(vl, vh, v0a, v1a, q); }
        if constexpr (I + 1 < 16) PVStep<I + 1>::run(vl, vh, v0a, v1a, q, pf, O);
    }
};
template <int OFF> __device__ __forceinline__ bf16x8 k_read(unsigned a) { u32x4 r; asm volatile("ds_read_b128 %0, %1 offset:%2" : "=&v"(r) : "v"(a), "i"(OFF) : "memory"); return *reinterpret_cast<bf16x8*>(&r); }
#define KWAIT(n) do { asm volatile("s_waitcnt lgkmcnt(" #n ")" ::: "memory"); SBAR(); } while (0)
template <int I, int N> struct QKStep {
    template <int KS> static __device__ __forceinline__ void run(bf16x8 (&kf)[N], const unsigned (&ad)[KS], const bf16x8 (&qf)[KS], f32x16& S0, f32x16& S1) {
        constexpr int PRE = 8, LEFT = N - 1 - I, W = LEFT < PRE - 1 ? LEFT : PRE - 1;
        lgk_wait_k<W>(kf[I]);
        if constexpr ((I & 1) == 0) S0 = MFMA32(kf[I], qf[I >> 1], S0); else S1 = MFMA32(kf[I], qf[I >> 1], S1);
        SBAR();
        if constexpr (I + PRE < N) { kf[I + PRE] = k_read<((I + PRE) & 1) * 8192>(ad[(I + PRE) >> 1]); }
        if constexpr (I + 1 < N) QKStep<I + 1, N>::template run<KS>(kf, ad, qf, S0, S1);
    }
};
template <int KS, bool SCALE>
__device__ __forceinline__ void qk_tile(const LAS unsigned char* Kb, const bf16x8 (&qf)[KS], int kc0, const LaneGeo& g, float cs, f32x16& S0, f32x16& S1) {
    S0 = (f32x16){0.f, 0.f, 0.f, 0.f, 0.f, 0.f, 0.f, 0.f, 0.f, 0.f, 0.f, 0.f, 0.f, 0.f, 0.f, 0.f}; S1 = S0;
    unsigned kb = (unsigned)(uintptr_t)Kb + g.krow; asm volatile("" : "+v"(kb));
    unsigned ad[KS];
#pragma unroll
    for (int ks = 0; ks < KS; ++ks) ad[ks] = kb + (((2 * (kc0 + ks) + g.h) ^ g.kx) << 4);
    SBAR();
    bf16x8 kf[2 * KS];
    kf[0] = k_read<0>(ad[0]); kf[1] = k_read<8192>(ad[0]); kf[2] = k_read<0>(ad[1]); kf[3] = k_read<8192>(ad[1]);
    kf[4] = k_read<0>(ad[2]); kf[5] = k_read<8192>(ad[2]); kf[6] = k_read<0>(ad[3]); kf[7] = k_read<8192>(ad[3]);
    QKStep<0, 2 * KS>::template run<KS>(kf, ad, qf, S0, S1);
    SBAR();
    if constexpr (SCALE) {
#pragma unroll
        for (int i = 0; i < 16; ++i) { S0[i] *= cs; S1[i] *= cs; } }
}
struct SoftState { float m, l; };
#define ZERO16_ (f32x16){0.f, 0.f, 0.f, 0.f, 0.f, 0.f, 0.f, 0.f, 0.f, 0.f, 0.f, 0.f, 0.f, 0.f, 0.f, 0.f}
template <int KS, class MK>
__device__ __forceinline__ void attn_tile(const LAS unsigned char* Kb, unsigned Vaddr, const bf16x8 (&qf)[KS], int kc0, const LaneGeo& g, int kbase, int cls, const MK& mk, float cs,
                                          f32x16 (&O)[4], SoftState& st) {
    f32x16 S0, S1;
    qk_tile<KS, false>(Kb, qf, kc0, g, cs, S0, S1);
    s16x4 vl[16], vh[16];
    unsigned v0a = Vaddr + g.va0, v1a = Vaddr + g.va1; asm volatile("" : "+v"(v0a), "+v"(v1a));
    v_issue<0>(vl, vh, v0a, v1a, g.q); v_issue<1>(vl, vh, v0a, v1a, g.q); v_issue<2>(vl, vh, v0a, v1a, g.q); v_issue<3>(vl, vh, v0a, v1a, g.q);
    v_issue<4>(vl, vh, v0a, v1a, g.q); v_issue<5>(vl, vh, v0a, v1a, g.q); v_issue<6>(vl, vh, v0a, v1a, g.q); v_issue<7>(vl, vh, v0a, v1a, g.q);
    if (cls == 2) {
        asm volatile("" ::: "memory");
#pragma unroll
        for (int i = 0; i < 16; ++i) { const int key = kbase + crow(i, g.h); S0[i] = mk.valid(key) ? S0[i] : NEGS; S1[i] = mk.valid(key + 32) ? S1[i] : NEGS; }
    }
    float mx = fmaxf(S0[0], S1[0]);
#pragma unroll
    for (int i = 1; i < 16; ++i) mx = fmaxf(mx, fmaxf(S0[i], S1[i]));
    const bool dead = (cls == 3) && !mk.lane_on();
    mx = dead ? NEGS : mx;
    mx = max32(mx);
    const float mn = fmaxf(st.m, mx), alpha = fast_exp2((st.m - mn) * cs), mc = dead ? -1e30f : -mn * cs; st.m = mn;
    float ps = 0.f;
#pragma unroll
    for (int i = 0; i < 16; ++i) { S0[i] = fast_exp2(fmaf(S0[i], cs, mc)); S1[i] = fast_exp2(fmaf(S1[i], cs, mc)); ps += S0[i] + S1[i]; }
    st.l = st.l * alpha + ps;
    if (!__all(alpha == 1.0f)) {
        asm volatile("" ::: "memory");
#pragma unroll
        for (int c = 0; c < 4; ++c)
#pragma unroll
            for (int i = 0; i < 16; ++i) O[c][i] *= alpha;
    }
    bf16x8 pf[4];
    { u32x4 w;
      w.x = cvt_pk_bf16(S0[0], S0[1]); w.y = cvt_pk_bf16(S0[2], S0[3]); w.z = cvt_pk_bf16(S0[4], S0[5]); w.w = cvt_pk_bf16(S0[6], S0[7]); pf[0] = *reinterpret_cast<bf16x8*>(&w);
      w.x = cvt_pk_bf16(S0[8], S0[9]); w.y = cvt_pk_bf16(S0[10], S0[11]); w.z = cvt_pk_bf16(S0[12], S0[13]); w.w = cvt_pk_bf16(S0[14], S0[15]); pf[1] = *reinterpret_cast<bf16x8*>(&w);
      w.x = cvt_pk_bf16(S1[0], S1[1]); w.y = cvt_pk_bf16(S1[2], S1[3]); w.z = cvt_pk_bf16(S1[4], S1[5]); w.w = cvt_pk_bf16(S1[6], S1[7]); pf[2] = *reinterpret_cast<bf16x8*>(&w);
      w.x = cvt_pk_bf16(S1[8], S1[9]); w.y = cvt_pk_bf16(S1[10], S1[11]); w.z = cvt_pk_bf16(S1[12], S1[13]); w.w = cvt_pk_bf16(S1[14], S1[15]); pf[3] = *reinterpret_cast<bf16x8*>(&w); }
    SBAR();
    PVStep<0>::run(vl, vh, v0a, v1a, g.q, pf, O);
}
struct DmaOff { unsigned o[2]; };
__device__ __forceinline__ DmaOff dma_offsets(int ld, int wave, int lane) {
    DmaOff d;
#pragma unroll
    for (int i = 0; i < 2; ++i) { const int inst = wave + 8 * i, row = 4 * inst + (lane >> 4), chs = (lane & 15) ^ (((row & 3) << 2) | ((row >> 2) & 3)); d.o[i] = (unsigned)(row * ld + 8 * chs) * 2u; }
    return d;
}
__device__ __forceinline__ void tile_dma(LAS unsigned char* dst, const bf16_t* src, int ld, int key0, int wave, const DmaOff& d) {
    const char* base = (const char*)(src + (size_t)key0 * ld);
    unsigned z = 0u; asm volatile("" : "+v"(z));
#pragma unroll
    for (int i = 0; i < 2; ++i) __builtin_amdgcn_global_load_lds((const unsigned*)(base + (((unsigned long long)z << 32) | d.o[i])), (LAS unsigned*)(dst + (wave + 8 * i) * 1024), 16, 0, 0);
}
constexpr float SM_THR = 8.0f;
#define PIN(x) asm volatile("" : "+v"(x))
struct ParState { float mxa, mxb, alpha, mc; };
template <int I> __device__ __forceinline__ void fin_slice(f32x16& F0, f32x16& F1, float& ps, unsigned (&w0)[8], unsigned (&w1)[8]) {
    F0[I] = fast_exp2(F0[I]); F1[I] = fast_exp2(F1[I]); ps += F0[I] + F1[I];
    if constexpr ((I & 1) == 1) { w0[I >> 1] = cvt_pk_bf16(F0[I - 1], F0[I]); w1[I >> 1] = cvt_pk_bf16(F1[I - 1], F1[I]); PIN(w0[I >> 1]); PIN(w1[I >> 1]); }
    else { PIN(F0); PIN(F1); }
    PIN(ps);
}
template <int E> __device__ __forceinline__ void expo(f32x16& N0, f32x16& N1, float cs, float mc) { if constexpr (E < 16) N0[E] = fmaf(N0[E], cs, mc); else if constexpr (E < 32) N1[E - 16] = fmaf(N1[E - 16], cs, mc); }
template <int I> __device__ __forceinline__ void par_slice(f32x16& N0, f32x16& N1, ParState& ps, SoftState& st, bool dead, float cs) {
    if constexpr (I < 8) { ps.mxa = fmaxf(fmaxf(ps.mxa, N0[2 * I]), N0[2 * I + 1]); ps.mxb = fmaxf(fmaxf(ps.mxb, N1[2 * I]), N1[2 * I + 1]); }
    else if constexpr (I == 8) {
        float mx = fmaxf(ps.mxa, ps.mxb); mx = dead ? NEGS : mx; mx = max32(mx);
        const bool defer = __all((mx - st.m) * cs <= SM_THR);
        const float mn = defer ? st.m : fmaxf(st.m, mx);
        ps.alpha = defer ? 1.0f : fast_exp2((st.m - mn) * cs); ps.mc = dead ? -1e30f : -mn * cs; st.m = mn;
    } else { constexpr int E0 = 5 * (I - 9); expo<E0>(N0, N1, cs, ps.mc); expo<E0 + 1>(N0, N1, cs, ps.mc); expo<E0 + 2>(N0, N1, cs, ps.mc); expo<E0 + 3>(N0, N1, cs, ps.mc); expo<E0 + 4>(N0, N1, cs, ps.mc); }
    if constexpr (I < 8) { PIN(ps.mxa); PIN(ps.mxb); } else if constexpr (I == 8) { PIN(ps.alpha); PIN(ps.mc); PIN(st.m); } else { PIN(N0); PIN(N1); }
}
template <int I, int N, int KS, int PRE, int KOFF> struct QKF {
    static __device__ __forceinline__ void run(bf16x8 (&kf)[N], const unsigned (&ad)[KS], const bf16x8 (&qf)[KS], f32x16& N0, f32x16& N1, f32x16& F0, f32x16& F1, float& ps, unsigned (&w0)[8], unsigned (&w1)[8]) {
        constexpr int LEFT = N - 1 - I, W = LEFT < PRE - 1 ? LEFT : PRE - 1;
        lgk_wait_k<W>(kf[I]);
        if constexpr ((I & 1) == 0) N0 = MFMA32(kf[I], qf[I >> 1], N0); else N1 = MFMA32(kf[I], qf[I >> 1], N1);
        SBAR();
        if constexpr (I + PRE < N) { kf[I + PRE] = k_read<KOFF + ((I + PRE) & 1) * 8192>(ad[(I + PRE) >> 1]); }
        constexpr int SPS = 16 / N;
        fin_slice<I * SPS>(F0, F1, ps, w0, w1);
        if constexpr (SPS == 2) fin_slice<I * SPS + 1>(F0, F1, ps, w0, w1);
        if constexpr (I + 1 < N) QKF<I + 1, N, KS, PRE, KOFF>::run(kf, ad, qf, N0, N1, F0, F1, ps, w0, w1);
    }
};
template <int I, int VOFF> __device__ __forceinline__ void v_issue2(s16x4 (&vl)[16], s16x4 (&vh)[16], const unsigned (&va)[8]) {
    constexpr int c = I >> 2, kk = I & 3;
    vl[I] = tr_read<VOFF + 4096 * kk>(va[c]); vh[I] = tr_read<VOFF + 4096 * kk>(va[4 + c]);
}
template <int I, int VOFF> struct PVP {
    static __device__ __forceinline__ void run(s16x4 (&vl)[16], s16x4 (&vh)[16], const unsigned (&va)[8], const bf16x8 (&pf)[4], f32x16 (&O)[4],
                                               f32x16& N0, f32x16& N1, ParState& ps, SoftState& st, bool dead, float cs) {
        constexpr int LEFT = 15 - I, W = LEFT < 7 ? 2 * LEFT : 14;
        lgk_wait_v<W>(vl[I], vh[I]);
        O[I >> 2] = MFMA32(PKV(vl[I], vh[I]), pf[I & 3], O[I >> 2]);
        SBAR();
        if constexpr (I + 8 < 16) { v_issue2<I + 8, VOFF>(vl, vh, va); }
        par_slice<I>(N0, N1, ps, st, dead, cs);
        if constexpr (I + 1 < 16) PVP<I + 1, VOFF>::run(vl, vh, va, pf, O, N0, N1, ps, st, dead, cs);
    }
};
template <int I, int VOFF> struct PVOnly {
    static __device__ __forceinline__ void run(s16x4 (&vl)[16], s16x4 (&vh)[16], const unsigned (&va)[8], const bf16x8 (&pf)[4], f32x16 (&O)[4]) {
        constexpr int LEFT = 15 - I, W = LEFT < 7 ? 2 * LEFT : 14;
        lgk_wait_v<W>(vl[I], vh[I]);
        O[I >> 2] = MFMA32(PKV(vl[I], vh[I]), pf[I & 3], O[I >> 2]);
        SBAR();
        if constexpr (I + 8 < 16) { v_issue2<I + 8, VOFF>(vl, vh, va); }
        if constexpr (I + 1 < 16) PVOnly<I + 1, VOFF>::run(vl, vh, va, pf, O);
    }
};
template <int I> struct ParAlone { static __device__ __forceinline__ void run(f32x16& N0, f32x16& N1, ParState& ps, SoftState& st, bool dead, float cs) { par_slice<I>(N0, N1, ps, st, dead, cs); if constexpr (I + 1 < 16) ParAlone<I + 1>::run(N0, N1, ps, st, dead, cs); } };
template <int I> struct FinAlone { static __device__ __forceinline__ void run(f32x16& F0, f32x16& F1, float& ps, unsigned (&w0)[8], unsigned (&w1)[8]) { fin_slice<I>(F0, F1, ps, w0, w1); if constexpr (I + 1 < 16) FinAlone<I + 1>::run(F0, F1, ps, w0, w1); } };
template <class MK>
__device__ __forceinline__ bool tile_mask(f32x16& N0, f32x16& N1, const LaneGeo& g, int kbase, int cls, const MK& mk) {
    if (cls == 2) {
        asm volatile("" ::: "memory");
#pragma unroll
        for (int i = 0; i < 16; ++i) { const int key = kbase + crow(i, g.h); N0[i] = mk.valid(key) ? N0[i] : NEGS; N1[i] = mk.valid(key + 32) ? N1[i] : NEGS; }
    }
    return cls == 0 || (cls == 3 && !mk.lane_on());
}
__device__ __forceinline__ void pack_pf(const unsigned (&w0)[8], const unsigned (&w1)[8], bf16x8 (&pf)[4]) {
    u32x4 w;
    w.x = w0[0]; w.y = w0[1]; w.z = w0[2]; w.w = w0[3]; pf[0] = *reinterpret_cast<bf16x8*>(&w);
    w.x = w0[4]; w.y = w0[5]; w.z = w0[6]; w.w = w0[7]; pf[1] = *reinterpret_cast<bf16x8*>(&w);
    w.x = w1[0]; w.y = w1[1]; w.z = w1[2]; w.w = w1[3]; pf[2] = *reinterpret_cast<bf16x8*>(&w);
    w.x = w1[4]; w.y = w1[5]; w.z = w1[6]; w.w = w1[7]; pf[3] = *reinterpret_cast<bf16x8*>(&w);
}
__device__ __forceinline__ void o_rescale(f32x16 (&O)[4], float alpha) {
    if (!__all(alpha == 1.0f)) {
        asm volatile("" ::: "memory");
#pragma unroll
        for (int c = 0; c < 4; ++c)
#pragma unroll
            for (int i = 0; i < 16; ++i) O[c][i] *= alpha;
    }
}
template <int KS, class MK, int P>
__device__ __forceinline__ void stream_step(LAS unsigned char* lds, const bf16_t* K, const bf16_t* V, int ldk, int ldv, int kt0, int j, int nt, int wave, const DmaOff& dof,
                                            const bf16x8 (&qf)[KS], const unsigned (&ad)[KS], const unsigned (&va)[8], const LaneGeo& g, MK& mk, float cs, f32x16 (&O)[4], SoftState& st,
                                            f32x16& F0, f32x16& F1, f32x16& N0, f32x16& N1, float& alF) {
    asm volatile("s_waitcnt vmcnt(0)" ::: "memory");
    __syncthreads();
    if (j + 1 < nt) tile_dma(lds + (1 - P) * 16384, K, ldk, (kt0 + j + 1) * 64, wave, dof);
    tile_dma(lds + 32768 + P * 16384, V, ldv, (kt0 + j) * 64, wave, dof);
    const int kbase = (kt0 + j) * 64, cls = mk.prep(kbase);
    N0 = ZERO16_; N1 = ZERO16_;
    constexpr int KOFF = P * 16384, VOFF = 32768 + (1 - P) * 16384;
    SBAR();
    bf16x8 kf[2 * KS];
    kf[0] = k_read<KOFF>(ad[0]); kf[1] = k_read<KOFF + 8192>(ad[0]); kf[2] = k_read<KOFF>(ad[1]); kf[3] = k_read<KOFF + 8192>(ad[1]);
    if constexpr (MK::KPRE == 8) { kf[4] = k_read<KOFF>(ad[2]); kf[5] = k_read<KOFF + 8192>(ad[2]); kf[6] = k_read<KOFF>(ad[3]); kf[7] = k_read<KOFF + 8192>(ad[3]); }
    float ps = 0.f; unsigned w0[8], w1[8];
    QKF<0, 2 * KS, KS, MK::KPRE, KOFF>::run(kf, ad, qf, N0, N1, F0, F1, ps, w0, w1);
    SBAR();
    st.l = st.l * alF + ps; PIN(st.l);
    bf16x8 pf[4]; pack_pf(w0, w1, pf);
    const bool dead = tile_mask<MK>(N0, N1, g, kbase, cls, mk);
    s16x4 vl[16], vh[16];
    SBAR();
    v_issue2<0, VOFF>(vl, vh, va); v_issue2<1, VOFF>(vl, vh, va); v_issue2<2, VOFF>(vl, vh, va); v_issue2<3, VOFF>(vl, vh, va);
    v_issue2<4, VOFF>(vl, vh, va); v_issue2<5, VOFF>(vl, vh, va); v_issue2<6, VOFF>(vl, vh, va); v_issue2<7, VOFF>(vl, vh, va);
    ParState pr; pr.mxa = NEGS; pr.mxb = NEGS; pr.alpha = 1.0f; pr.mc = 0.f;
    PVP<0, VOFF>::run(vl, vh, va, pf, O, N0, N1, pr, st, dead, cs);
    SBAR();
    o_rescale(O, pr.alpha);
    alF = pr.alpha;
}
__device__ __forceinline__ void stream_tail(const unsigned (&va)[8], f32x16 (&O)[4], SoftState& st, f32x16& F0, f32x16& F1, float alF) {
    float ps = 0.f; unsigned w0[8], w1[8];
    FinAlone<0>::run(F0, F1, ps, w0, w1);
    st.l = st.l * alF + ps; PIN(st.l);
    bf16x8 pf[4]; pack_pf(w0, w1, pf);
    s16x4 vl[16], vh[16];
    constexpr int VOFF = 32768;
    SBAR();
    v_issue2<0, VOFF>(vl, vh, va); v_issue2<1, VOFF>(vl, vh, va); v_issue2<2, VOFF>(vl, vh, va); v_issue2<3, VOFF>(vl, vh, va);
    v_issue2<4, VOFF>(vl, vh, va); v_issue2<5, VOFF>(vl, vh, va); v_issue2<6, VOFF>(vl, vh, va); v_issue2<7, VOFF>(vl, vh, va);
    SBAR();
    PVOnly<0, VOFF>::run(vl, vh, va, pf, O);
}
template <int KS, class MK>
__device__ __forceinline__ void attn_stream(LAS unsigned char* lds, const bf16_t* K, const bf16_t* V, int ldk, int ldv, int kt0, int nt, int wave, int lane,
                                            const bf16x8 (&qf)[KS], int kc0, const LaneGeo& g, MK& mk, float cs, f32x16 (&O)[4], SoftState& st) {
    const DmaOff dof = dma_offsets(ldk, wave, lane);
    unsigned ad[KS], va[8];
    { const unsigned kb = (unsigned)(uintptr_t)lds + g.krow;
#pragma unroll
      for (int ks = 0; ks < KS; ++ks) { ad[ks] = kb + (((2 * (kc0 + ks) + g.h) ^ g.kx) << 4); PIN(ad[ks]); }
      const unsigned vb = (unsigned)(uintptr_t)lds;
#pragma unroll
      for (int c = 0; c < 4; ++c) { va[c] = vb + g.va0 + 64u * ((unsigned)c ^ g.q); va[4 + c] = vb + g.va1 + 64u * ((unsigned)c ^ g.q); PIN(va[c]); PIN(va[4 + c]); } }
    f32x16 A0, A1, B0, B1; float alF;
    __syncthreads();
    tile_dma(lds, K, ldk, kt0 * 64, wave, dof);
    asm volatile("s_waitcnt vmcnt(0)" ::: "memory");
    __syncthreads();
    if (nt > 1) tile_dma(lds + 16384, K, ldk, (kt0 + 1) * 64, wave, dof);
    tile_dma(lds + 32768, V, ldv, kt0 * 64, wave, dof);
    { const int kbase = kt0 * 64, cls = mk.prep(kbase);
      A0 = ZERO16_; A1 = ZERO16_;
      bf16x8 kf[2 * KS];
      kf[0] = k_read<0>(ad[0]); kf[1] = k_read<8192>(ad[0]); kf[2] = k_read<0>(ad[1]); kf[3] = k_read<8192>(ad[1]);
      kf[4] = k_read<0>(ad[2]); kf[5] = k_read<8192>(ad[2]); kf[6] = k_read<0>(ad[3]); kf[7] = k_read<8192>(ad[3]);
      QKStep<0, 2 * KS>::template run<KS>(kf, ad, qf, A0, A1);
      SBAR();
      const bool dead = tile_mask<MK>(A0, A1, g, kbase, cls, mk);
      ParState pr; pr.mxa = NEGS; pr.mxb = NEGS; pr.alpha = 1.0f; pr.mc = 0.f;
      ParAlone<0>::run(A0, A1, pr, st, dead, cs); alF = pr.alpha; }
    int j = 1;
    for (; j + 1 < nt; j += 2) {
        stream_step<KS, MK, 1>(lds, K, V, ldk, ldv, kt0, j, nt, wave, dof, qf, ad, va, g, mk, cs, O, st, A0, A1, B0, B1, alF);
        stream_step<KS, MK, 0>(lds, K, V, ldk, ldv, kt0, j + 1, nt, wave, dof, qf, ad, va, g, mk, cs, O, st, B0, B1, A0, A1, alF);
    }
    unsigned vslot = 0u;
    if (j < nt) {
        stream_step<KS, MK, 1>(lds, K, V, ldk, ldv, kt0, j, nt, wave, dof, qf, ad, va, g, mk, cs, O, st, A0, A1, B0, B1, alF);
        A0 = B0; A1 = B1; vslot = 16384u;
    }
    asm volatile("s_waitcnt vmcnt(0)" ::: "memory");
    __syncthreads();
#pragma unroll
    for (int i = 0; i < 8; ++i) va[i] += vslot;
    stream_tail(va, O, st, A0, A1, alF);
    __syncthreads();
}
struct MaskCausal { static constexpr int KPRE = 8; int qpos, wlo;
    __device__ __forceinline__ int prep(int kbase) { if (kbase > wlo + 31) return 0; return (kbase + 63 <= wlo) ? 1 : 2; }
    __device__ __forceinline__ bool valid(int key) const { return key <= qpos; }
    __device__ __forceinline__ bool lane_on() const { return true; } };
struct MaskMoba { static constexpr int KPRE = 4; int qpos, wlo, own; unsigned bits; bool lanebit, diag;
    __device__ __forceinline__ int prep(int kbase) { const int blk = kbase >> 8;
        if (blk == own) { diag = true; if (kbase > wlo + 31) return 0; return (kbase + 63 <= wlo) ? 1 : 2; }
        diag = false; lanebit = (bits >> blk) & 1u; return __all(lanebit) ? 1 : (__any(lanebit) ? 3 : 0); }
    __device__ __forceinline__ bool valid(int key) const { return key <= qpos; }
    __device__ __forceinline__ bool lane_on() const { return lanebit; } };
struct MaskSel { static constexpr int KPRE = 4; int qpos, cur; unsigned long long bits; bool lanebit, diag;
    __device__ __forceinline__ int prep(int kbase) { const int kt = kbase >> 6;
        if (kt == cur) { diag = true; return 2; }
        diag = false; lanebit = (bits >> kt) & 1ull; return __all(lanebit) ? 1 : (__any(lanebit) ? 3 : 0); }
    __device__ __forceinline__ bool valid(int key) const { return key <= qpos; }
    __device__ __forceinline__ bool lane_on() const { return lanebit; } };
struct MaskWin { static constexpr int KPRE = 4; int qpos, wlo;
    __device__ __forceinline__ int prep(int kbase) { const int hi = wlo + 31; if (kbase > hi || kbase + 63 <= wlo - 512) return 0; return (kbase + 63 <= wlo && kbase > hi - 512) ? 1 : 2; }
    __device__ __forceinline__ bool valid(int key) const { return key <= qpos && key > qpos - 512; }
    __device__ __forceinline__ bool lane_on() const { return true; } };
struct MaskCmp { static constexpr int KPRE = 4; int qpos, wlo;
    __device__ __forceinline__ int prep(int kbase) { if (16 * kbase > wlo) return 0; return (16 * (kbase + 63) + 31 <= wlo) ? 1 : 2; }
    __device__ __forceinline__ bool valid(int key) const { return 16 * key + 31 <= qpos; }
    __device__ __forceinline__ bool lane_on() const { return true; } };

constexpr float LOG2E = 1.44269504088896340736f;
__device__ __forceinline__ void store_ot_bf16(const f32x16 (&O)[4], float sc, bf16_t* dst, int h) {
#pragma unroll
    for (int c = 0; c < 4; ++c)
#pragma unroll
        for (int q = 0; q < 4; q += 2) {
            u32x2 a, b;
            a.x = cvt_pk_bf16(O[c][4 * q] * sc, O[c][4 * q + 1] * sc); a.y = cvt_pk_bf16(O[c][4 * q + 2] * sc, O[c][4 * q + 3] * sc);
            b.x = cvt_pk_bf16(O[c][4 * q + 4] * sc, O[c][4 * q + 5] * sc); b.y = cvt_pk_bf16(O[c][4 * q + 6] * sc, O[c][4 * q + 7] * sc);
            auto r0 = __builtin_amdgcn_permlane32_swap(a.x, b.x, false, false); a.x = r0[0]; b.x = r0[1];
            auto r1 = __builtin_amdgcn_permlane32_swap(a.y, b.y, false, false); a.y = r1[0]; b.y = r1[1];
            *(u32x4*)(dst + 32 * c + 8 * (q + h)) = (u32x4){a.x, a.y, b.x, b.y}; }
}
#define ZERO16 (f32x16){0.f, 0.f, 0.f, 0.f, 0.f, 0.f, 0.f, 0.f, 0.f, 0.f, 0.f, 0.f, 0.f, 0.f, 0.f, 0.f}

__device__ __forceinline__ void phase_kmean(const Frame& F) {
    const bf16_t* qkv = (const bf16_t*)(F.ws + WS_QKV); bf16_t* km = (bf16_t*)(F.ws + WS_KMEAN);
    LAS float* part = (LAS float*)(F.lds + MISC_OFF + MO_GEN);
    for (int base = 2 * F.bid; base < NB * 8 * 16; base += 2 * F.G) {
        const int it = base + (F.wave >> 2), quarter = F.wave & 3, blk = it & 15, bh = it >> 4, b = bh >> 3, hh = bh & 7, rg = F.lane >> 4, ch = F.lane & 15;
        const bf16_t* p = qkv + ((size_t)b * SEQ + 256 * blk + 64 * quarter + 16 * rg) * N0 + 4096 + hh * 128 + 8 * ch;
        float s[8] = {0.f, 0.f, 0.f, 0.f, 0.f, 0.f, 0.f, 0.f};
        u32x4 q[16];
#pragma unroll
        for (int i = 0; i < 16; ++i) q[i] = *(const u32x4*)(p + (size_t)i * N0);
#pragma unroll
        for (int i = 0; i < 16; ++i) { s[0] += bflo(q[i].x); s[1] += bfhi(q[i].x); s[2] += bflo(q[i].y); s[3] += bfhi(q[i].y); s[4] += bflo(q[i].z); s[5] += bfhi(q[i].z); s[6] += bflo(q[i].w); s[7] += bfhi(q[i].w); }
#pragma unroll
        for (int j = 0; j < 8; ++j) { s[j] += swz_xor<16>(s[j]); s[j] = sum32(s[j]); }
        __syncthreads();
        if (F.lane < 16) {
#pragma unroll
            for (int j = 0; j < 8; ++j) part[F.wave * 128 + 8 * ch + j] = s[j]; }
        __syncthreads();
        if (quarter == 0 && F.lane < 16) {
            float t[8];
#pragma unroll
            for (int j = 0; j < 8; ++j) t[j] = ((part[F.wave * 128 + 8 * ch + j] + part[(F.wave + 1) * 128 + 8 * ch + j]) + (part[(F.wave + 2) * 128 + 8 * ch + j] + part[(F.wave + 3) * 128 + 8 * ch + j])) * (1.0f / 256.0f);
            u32x4 w; w.x = cvt_pk_bf16(t[0], t[1]); w.y = cvt_pk_bf16(t[2], t[3]); w.z = cvt_pk_bf16(t[4], t[5]); w.w = cvt_pk_bf16(t[6], t[7]);
            *(u32x4*)(km + ((size_t)bh * 32 + blk) * 128 + 8 * ch) = w; unsigned z = 0u; asm volatile("" : "+v"(z)); *(u32x4*)(km + ((size_t)bh * 32 + 16 + blk) * 128 + 8 * ch) = (u32x4){z, z, z, z}; }
    }
}

__device__ __forceinline__ void diff_unit(const Frame& F0, const Args& A, int b, int hh, int qb) {
    Frame F = F0; F.lane = fresh_lane(); F.tid = F.wave * 64 + F.lane; { unsigned long long w_ = (unsigned long long)F0.ws; asm volatile("" : "+s"(w_)); F.ws = (unsigned char*)(GAS unsigned char*)w_; }
    const bf16_t* qkv = (const bf16_t*)(F.ws + WS_QKV); bf16_t* att = (bf16_t*)(F.ws + WS_ATT);
    const LaneGeo g = lane_geo(F.lane);
    const int rg = F.wave & 3, map = F.wave >> 2, wlo = 128 * qb + 32 * rg, pos = wlo + g.r; const size_t tok = (size_t)b * SEQ + pos;
    bf16x8 qf[4];
#pragma unroll
    for (int ks = 0; ks < 4; ++ks) qf[ks] = *(const bf16x8*)(qkv + tok * N0 + hh * 128 + 64 * map + 16 * ks + 8 * g.h);
    f32x16 O[4] = {ZERO16, ZERO16, ZERO16, ZERO16}; SoftState st; st.m = NEGS; st.l = 0.f;
    MaskCausal mk; mk.qpos = pos; mk.wlo = wlo;
    const bf16_t* Kp = qkv + (size_t)b * SEQ * N0 + 1024 + hh * 128; const bf16_t* Vp = qkv + (size_t)b * SEQ * N0 + 2048 + hh * 128;
    attn_stream<4, MaskCausal>(F.lds, Kp, Vp, N0, N0, 0, 2 * qb + 2, F.wave, F.lane, qf, 4 * map, g, mk, 0.125f * LOG2E, O, st);
    const float inv = 1.0f / sum32(st.l);
    LAS float* xch = (LAS float*)(F.lds + rg * 16384);
    if (map == 1) {
#pragma unroll
        for (int c = 0; c < 4; ++c)
#pragma unroll
            for (int i = 0; i < 16; ++i) xch[(c * 16 + i) * 64 + F.lane] = O[c][i] * inv;
    }
    __syncthreads();
    if (map == 0) {
        const float sa = wave_sum(inp(2)[F.lane] * inp(3)[F.lane]), sb = wave_sum(inp(4)[F.lane] * inp(5)[F.lane]);
        const float lam = __expf(sa) - __expf(sb) + 0.2f;
        float ss = 0.f;
#pragma unroll
        for (int c = 0; c < 4; ++c) {
#pragma unroll
            for (int i = 0; i < 16; ++i) { const float o = O[c][i] * inv - lam * xch[(c * 16 + i) * 64 + F.lane]; O[c][i] = o; ss += o * o; }
            asm volatile("" ::: "memory"); }
        ss = sum32(ss);
        const float rn = 0.8f / sqrtf(ss * (1.0f / 128.0f) + LN_EPS);
        const float* sg = inp(6);
#pragma unroll
        for (int c = 0; c < 4; ++c) {
#pragma unroll
            for (int q = 0; q < 4; ++q) { const f32x4 gg = *(const f32x4*)(sg + 32 * c + 8 * q + 4 * g.h);
                O[c][4 * q] *= gg[0]; O[c][4 * q + 1] *= gg[1]; O[c][4 * q + 2] *= gg[2]; O[c][4 * q + 3] *= gg[3]; }
            asm volatile("" ::: "memory"); }
        store_ot_bf16(O, rn, att + tok * DM + hh * 128, g.h);
    }
    __syncthreads();
}
__device__ __forceinline__ void moba_unit(const Frame& F0, int b, int hh, int qb) {
    Frame F = F0; F.lane = fresh_lane(); F.tid = F.wave * 64 + F.lane; { unsigned long long w_ = (unsigned long long)F0.ws; asm volatile("" : "+s"(w_)); F.ws = (unsigned char*)(GAS unsigned char*)w_; }
    const bf16_t* qkv = (const bf16_t*)(F.ws + WS_QKV); bf16_t* att = (bf16_t*)(F.ws + WS_ATT);
    const LaneGeo g = lane_geo(F.lane);
    const int wlo = 256 * qb + 32 * F.wave, pos = wlo + g.r; const size_t tok = (size_t)b * SEQ + pos;
    bf16x8 qf[8];
#pragma unroll
    for (int ks = 0; ks < 8; ++ks) qf[ks] = *(const bf16x8*)(qkv + tok * N0 + 3072 + hh * 128 + 16 * ks + 8 * g.h);
    MaskMoba mk; mk.qpos = pos; mk.wlo = wlo; mk.own = qb; mk.bits = 0u; mk.lanebit = false; mk.diag = false;
    if (qb > 0) {
        const bf16_t* km = (const bf16_t*)(F.ws + WS_KMEAN) + (size_t)(b * 8 + hh) * 32 * 128;
        __syncthreads();
        { const int r = F.tid >> 4, ch = F.tid & 15; *(LAS u32x4*)(F.lds + offb(r, ch)) = *(const u32x4*)(km + r * 128 + 8 * ch); }
        __syncthreads();
        f32x16 G = ZERO16;
#pragma unroll
        for (int ks = 0; ks < 8; ++ks) { const unsigned o = g.krow + (((2 * ks + g.h) ^ g.kx) << 4); G = MFMA32(*(const LAS bf16x8*)(F.lds + o), qf[ks], G); }
        float gv[16];
#pragma unroll
        for (int i = 0; i < 8; ++i) { const float a = G[i], o = partner32(a, g.h); const int nb = (i & 3) + 8 * (i >> 2); gv[nb] = g.h ? o : a; gv[nb + 4] = g.h ? a : o; }
        unsigned picked = 0u, bits = 0u;
        for (int it = 0; it < 3; ++it) { float best = -3e38f; int bi = 0;
#pragma unroll
            for (int n = 0; n < 16; ++n) { const float v = n < qb ? gv[n] : NEGF; if (!((picked >> n) & 1u) && v > best) { best = v; bi = n; } }
            picked |= 1u << bi; if (bi < qb) bits |= 1u << bi; }
        mk.bits = bits;
    }
    f32x16 O[4] = {ZERO16, ZERO16, ZERO16, ZERO16}; SoftState st; st.m = NEGS; st.l = 0.f;
    const bf16_t* Kp = qkv + (size_t)b * SEQ * N0 + 4096 + hh * 128; const bf16_t* Vp = qkv + (size_t)b * SEQ * N0 + 5120 + hh * 128;
    attn_stream<8, MaskMoba>(F.lds, Kp, Vp, N0, N0, 0, 4 * qb + 4, F.wave, F.lane, qf, 0, g, mk, 0.08838834764831845f * LOG2E, O, st);
    const float inv = 1.0f / sum32(st.l);
    store_ot_bf16(O, inv, att + tok * DM + 1024 + hh * 128, g.h);
}
__device__ __forceinline__ void phase_attn0(const Frame& F, const Args& A) {
    for (int k = 0; k * F.G < 1024; ++k) { const int w = F.bid; const int rk = k * F.G + ((k & 1) ? F.G - 1 - w : w);
#ifndef NO_DIFF
        if (rk < 1024) { const int qb = 31 - rk / 32, bh = rk % 32; diff_unit(F, A, bh >> 3, bh & 7, qb); }
#endif
    }
    for (int k = 0; k * F.G < 512; ++k) { const int w = F.bid; const int rk = k * F.G + ((k & 1) ? F.G - 1 - w : w);
#ifndef NO_MOBA
        if (rk < 512) { const int qb = 15 - rk / 32, bh = rk % 32; moba_unit(F, bh >> 3, bh & 7, qb); }
#endif
    }
}

__device__ __forceinline__ float gelu_tanh(float x) { const float u = 0.7978845608028654f * (x + 0.044715f * x * x * x); const float e = __expf(2.0f * u); return 0.5f * x * (2.0f - 2.0f / (1.0f + e)); }
__device__ __forceinline__ void phase_compress(const Frame& F) {
    unsigned char* ws = F.ws; const bf16_t* qkv = (const bf16_t*)(ws + WS_QKV);
    const LaneGeo g = lane_geo(F.lane);
    for (int it = F.bid; it < 128; it += F.G) {
        const int kv = it >> 6, bg = (it >> 3) & 7, tile = it & 7, b = bg >> 1, gi = bg & 1;
        const bf16_t* w1t = (const bf16_t*)(ws + (kv ? WS_W1VT : WS_W1KT)); const bf16_t* w2t = (const bf16_t*)(ws + (kv ? WS_W2VT : WS_W2KT));
        const float* peb = (const float*)(ws + WS_PEB) + kv * 128;
        bf16_t* outp = (bf16_t*)(ws + (kv ? WS_VCMP : WS_KCMP)) + (size_t)bg * 256 * 128;
        const int n = 32 * tile + g.r, col0 = (kv ? 2304 : 2048) + gi * 128;
        __syncthreads();
        f32x16 acc[4] = {ZERO16, ZERO16, ZERO16, ZERO16};
#pragma unroll 8
        for (int kk = 0; kk < 32; ++kk) { const int ks = 32 * F.wave + kk, tl = ks >> 3, d = 16 * (ks & 7) + 8 * g.h;
            int tp = 16 * n + tl; tp = tp < SEQ ? tp : SEQ - 1;
            const bf16x8 bq = *(const bf16x8*)(qkv + ((size_t)b * SEQ + tp) * N1 + col0 + d);
#pragma unroll
            for (int blk = 0; blk < 4; ++blk) { const bf16x8 aq = *(const bf16x8*)(w1t + ((((size_t)blk * 256 + ks) * 64 + F.lane) << 3)); acc[blk] = MFMA32(aq, bq, acc[blk]); } }
        LAS float* part = (LAS float*)(F.lds + F.wave * 16384);
#pragma unroll
        for (int blk = 0; blk < 4; ++blk)
#pragma unroll
            for (int i = 0; i < 16; ++i) part[(blk * 16 + i) * 64 + F.lane] = acc[blk][i];
        __syncthreads();
        LAS bf16_t* hidT = (LAS bf16_t*)(F.lds + MISC_OFF + MO_GEN);
        for (int i = 0; i < 8; ++i) { const int idx = F.tid + 512 * i, ln = idx & 63, ri = idx >> 6, blk = ri >> 4, reg = ri & 15;
            float s = 0.f;
#pragma unroll
            for (int w = 0; w < 8; ++w) s += ((LAS float*)(F.lds + w * 16384))[idx];
            const int hidden = 32 * blk + crow(reg, ln >> 5);
            s = gelu_tanh(s + peb[hidden]);
            hidT[hidden * 32 + (ln & 31)] = (bf16_t)(cvt_pk_bf16(s, 0.f) & 0xffffu); }
        __syncthreads();
        if (F.wave < 4) {
            const int ob = F.wave; f32x16 o = ZERO16;
#pragma unroll
            for (int ks = 0; ks < 8; ++ks) { const bf16x8 aq = *(const bf16x8*)(w2t + (size_t)(32 * ob + g.r) * 128 + 16 * ks + 8 * g.h);
                bf16x8 bq;
#pragma unroll
                for (int j = 0; j < 8; ++j) bq[j] = (short)hidT[(16 * ks + 8 * g.h + j) * 32 + g.r];
                o = MFMA32(aq, bq, o); }
            const bool dead = (n >= 255);
#pragma unroll
            for (int q = 0; q < 4; ++q) { u32x2 w; w.x = cvt_pk_bf16(o[4 * q], o[4 * q + 1]); w.y = cvt_pk_bf16(o[4 * q + 2], o[4 * q + 3]); if (dead) { w.x = 0u; w.y = 0u; }
                *(u32x2*)(outp + (size_t)n * 128 + 32 * ob + 8 * q + 4 * g.h) = w; }
        }
    }
}

__device__ __forceinline__ float sigmoid_f(float x) { float e = __expf(-x); asm volatile("" : "+v"(e)); float d = 1.0f + e; asm volatile("" : "+v"(d)); return __builtin_amdgcn_rcpf(d); }
__device__ __forceinline__ void nsa_unit(const Frame& F0, int b, int gi, int pt) {
    Frame F = F0; F.lane = fresh_lane(); F.tid = F.wave * 64 + F.lane; { unsigned long long w_ = (unsigned long long)F0.ws; asm volatile("" : "+s"(w_)); F.ws = (unsigned char*)(GAS unsigned char*)w_; }
    unsigned char* ws = F.ws; const bf16_t* qkv = (const bf16_t*)(ws + WS_QKV); const bf16_t* qrot = (const bf16_t*)(ws + WS_QROT); bf16_t* att = (bf16_t*)(ws + WS_ATT);
    const LaneGeo g = lane_geo(F.lane);
    const int head = 8 * gi + F.wave, t0 = 32 * pt, pos = t0 + g.r, cur = t0 >> 6; const size_t tok = (size_t)b * SEQ + pos;
    const float cs = 0.08838834764831845f * LOG2E;
#define NSA_GATE(br, name) float name; { int p_ = pos; asm volatile("" : "+v"(p_)); name = sigmoid_f(bf2f(qkv[((size_t)b * SEQ + p_) * N1 + 3584 + head * 3 + (br)])); }
    unsigned OTp[4][8];
    bf16x8 qf[8];
#pragma unroll
    for (int ks = 0; ks < 8; ++ks) qf[ks] = *(const bf16x8*)(qkv + tok * N1 + head * 128 + 16 * ks + 8 * g.h);
    __syncthreads();
    { const bf16_t* kc = (const bf16_t*)(ws + WS_KCMP) + (size_t)(b * 2 + gi) * 256 * 128; const bf16_t* vc = (const bf16_t*)(ws + WS_VCMP) + (size_t)(b * 2 + gi) * 256 * 128;
#pragma unroll
      for (int i = 0; i < 8; ++i) { const int piece = F.tid + 512 * i, row = piece >> 4, ch = piece & 15; const unsigned o = (row >> 6) * 16384 + offb(row & 63, ch);
          *(LAS u32x4*)(F.lds + o) = *(const u32x4*)(kc + row * 128 + 8 * ch); *(LAS u32x4*)(F.lds + 65536 + o) = *(const u32x4*)(vc + row * 128 + 8 * ch); } }
    __syncthreads();
    MaskCmp mc; mc.qpos = pos; mc.wlo = t0;
    SoftState sc_; sc_.m = NEGS; sc_.l = 0.f;
    { f32x16 O[4] = {ZERO16, ZERO16, ZERO16, ZERO16};
#pragma unroll 1
      for (int j = 0; j < 4; ++j) { const int cls = mc.prep(64 * j); if (cls) attn_tile<8, MaskCmp>(F.lds + j * 16384, (unsigned)(uintptr_t)(F.lds + 65536 + j * 16384), qf, 0, g, 64 * j, cls, mc, cs, O, sc_); }
      const float lt = sum32(sc_.l); const bool ok = pos >= 31; NSA_GATE(0, g0); const float sc = ok ? g0 * __builtin_amdgcn_rcpf(lt) : 0.f;
#pragma unroll
      for (int c = 0; c < 4; ++c)
#pragma unroll
          for (int i = 0; i < 8; ++i) OTp[c][i] = cvt_pk_bf16(O[c][2 * i] * sc, O[c][2 * i + 1] * sc);
      sc_.l = ok ? __builtin_amdgcn_rcpf(lt) : 0.f; }
    __syncthreads();
    { LAS float* slab = (LAS float*)(F.lds + 65536) + (F.wave * 32 + g.r) * 64; float prevx = 0.f;
#pragma unroll 1
      for (int j = 0; j < 4; ++j) {
          if (mc.prep(64 * j) == 0) {
#pragma unroll
              for (int gq = 0; gq < 8; ++gq) slab[(16 * j + 2 * gq + g.h) ^ g.r] = 0.f;
              prevx = 0.f; continue; }
          f32x16 S0, S1; qk_tile<8, true>(F.lds + j * 16384, qf, 0, g, cs, S0, S1);
#pragma unroll
          for (int sub = 0; sub < 2; ++sub)
#pragma unroll
              for (int q = 0; q < 4; ++q) { float p[4];
#pragma unroll
                  for (int e = 0; e < 4; ++e) { const int key = 64 * j + 32 * sub + 8 * q + 4 * g.h + e; const float s = sub ? S1[4 * q + e] : S0[4 * q + e]; p[e] = mc.valid(key) ? fast_exp2(s - sc_.m * cs) * sc_.l : 0.f; }
                  const float a = (p[0] + p[1]) + (p[2] + 0.5f * p[3]), cy = 0.5f * p[3], x = partner32(cy, g.h);
                  const float tot = a + (g.h ? x : prevx); prevx = x;
                  const int jb = 16 * j + 8 * sub + 2 * q + g.h; slab[jb ^ g.r] = tot; } } }
    __syncthreads();
    LAS unsigned* selm = (LAS unsigned*)(F.lds + MISC_OFF + MO_GEN);
    { const int jb = F.lane;
      for (int pi = 0; pi < 4; ++pi) { const int pp = 4 * F.wave + pi; float v = 0.f;
#pragma unroll
          for (int w = 0; w < 8; ++w) v += ((LAS float*)(F.lds + 65536))[(w * 32 + pp) * 64 + (jb ^ pp)];
          const bool allowed = jb <= cur, forced = (jb == 0) || (jb == cur) || (jb == cur - 1);
          const float val = allowed ? (forced ? 1e4f : v) : NEGF;
          int rank = 0;
#pragma unroll
          for (int i = 0; i < 64; ++i) { const float vi = __int_as_float(__builtin_amdgcn_readlane(__float_as_int(val), i)); rank += (vi > val || (vi == val && i < jb)) ? 1 : 0; }
          const unsigned long long m = __ballot(rank < 16 && allowed);
          if (F.lane == 0) { selm[2 * pp] = (unsigned)m; selm[2 * pp + 1] = (unsigned)(m >> 32); } } }
    __syncthreads();
    LAS unsigned* park = (LAS unsigned*)(F.lds + 65536 + F.wave * 8192) + F.lane;
#pragma unroll
    for (int c = 0; c < 4; ++c)
#pragma unroll
        for (int i = 0; i < 8; ++i) park[(c * 8 + i) * 64] = OTp[c][i];
    { int p2 = pos; asm volatile("" : "+v"(p2)); const size_t tok2 = (size_t)b * SEQ + p2;
#pragma unroll
      for (int ks = 0; ks < 8; ++ks) qf[ks] = *(const bf16x8*)(qrot + tok2 * DM + head * 128 + 16 * ks + 8 * g.h); }
    { MaskSel ms; ms.qpos = pos; ms.cur = cur; ms.bits = (unsigned long long)selm[2 * g.r] | ((unsigned long long)selm[2 * g.r + 1] << 32); ms.lanebit = false; ms.diag = false;
      f32x16 O[4] = {ZERO16, ZERO16, ZERO16, ZERO16}; SoftState st; st.m = NEGS; st.l = 0.f;
      const bf16_t* Kp = qkv + (size_t)b * SEQ * N1 + 2560 + gi * 128; const bf16_t* Vp = qkv + (size_t)b * SEQ * N1 + 2816 + gi * 128;
      attn_stream<8, MaskSel>(F.lds, Kp, Vp, N1, N1, 0, cur + 1, F.wave, F.lane, qf, 0, g, ms, cs, O, st);
      NSA_GATE(1, g1); const float sc = g1 * __builtin_amdgcn_rcpf(sum32(st.l));
      LAS unsigned* park2 = (LAS unsigned*)(F.lds + 65536 + F.wave * 8192) + fresh_lane();
#pragma unroll
      for (int c = 0; c < 4; ++c)
#pragma unroll
          for (int i = 0; i < 8; ++i) { const unsigned w = park2[(c * 8 + i) * 64]; park2[(c * 8 + i) * 64] = cvt_pk_bf16(bflo(w) + O[c][2 * i] * sc, bfhi(w) + O[c][2 * i + 1] * sc); } }
    { MaskWin mw; mw.qpos = pos; mw.wlo = t0;
      f32x16 O[4] = {ZERO16, ZERO16, ZERO16, ZERO16}; SoftState st; st.m = NEGS; st.l = 0.f;
      const int kt0 = t0 >= 511 ? (t0 - 511) >> 6 : 0;
      const bf16_t* Kp = qkv + (size_t)b * SEQ * N1 + 3072 + gi * 128; const bf16_t* Vp = qkv + (size_t)b * SEQ * N1 + 3328 + gi * 128;
      attn_stream<8, MaskWin>(F.lds, Kp, Vp, N1, N1, kt0, cur - kt0 + 1, F.wave, F.lane, qf, 0, g, mw, cs, O, st);
      NSA_GATE(2, g2); const float sc = g2 * __builtin_amdgcn_rcpf(sum32(st.l));
      int p3 = pos; asm volatile("" : "+v"(p3));
      bf16_t* dst = att + ((size_t)b * SEQ + p3) * DM + head * 128;
      const int ln3 = fresh_lane(), h3 = ln3 >> 5; LAS unsigned* park3 = (LAS unsigned*)(F.lds + 65536 + F.wave * 8192) + ln3;
#pragma unroll
      for (int c = 0; c < 4; ++c)
#pragma unroll
          for (int q = 0; q < 4; q += 2) { u32x2 a, b;
              { const unsigned w0 = park3[(c * 8 + 2 * q) * 64], w1 = park3[(c * 8 + 2 * q + 1) * 64];
                a.x = cvt_pk_bf16(bflo(w0) + O[c][4 * q] * sc, bfhi(w0) + O[c][4 * q + 1] * sc); a.y = cvt_pk_bf16(bflo(w1) + O[c][4 * q + 2] * sc, bfhi(w1) + O[c][4 * q + 3] * sc); }
              { const unsigned w0 = park3[(c * 8 + 2 * q + 2) * 64], w1 = park3[(c * 8 + 2 * q + 3) * 64];
                b.x = cvt_pk_bf16(bflo(w0) + O[c][4 * q + 4] * sc, bfhi(w0) + O[c][4 * q + 5] * sc); b.y = cvt_pk_bf16(bflo(w1) + O[c][4 * q + 6] * sc, bfhi(w1) + O[c][4 * q + 7] * sc); }
              auto r0 = __builtin_amdgcn_permlane32_swap(a.x, b.x, false, false); a.x = r0[0]; b.x = r0[1];
              auto r1 = __builtin_amdgcn_permlane32_swap(a.y, b.y, false, false); a.y = r1[0]; b.y = r1[1];
              *(u32x4*)(dst + 32 * c + 8 * (q + h3)) = (u32x4){a.x, a.y, b.x, b.y}; } }
}
__device__ __forceinline__ void phase_attn1(const Frame& F) {
    for (int k = 0; k * F.G < 1024; ++k) { const int w = F.bid; const int rk = k * F.G + ((k & 1) ? F.G - 1 - w : w);
        if (rk < 1024) { const int pt = 127 - rk / 8, bg = rk % 8; nsa_unit(F, bg >> 1, bg & 1, pt); } }
}

constexpr int N_LAUNCHES = MK_N_LAUNCHES;
__global__ void __launch_bounds__(512, 2) fwd(Args args) {
    extern __shared__ __attribute__((aligned(16))) unsigned char lds_raw[];
    Frame F;
    F.lds = (LAS unsigned char*)lds_raw; F.ws = args.ws; F.ctl = (unsigned*)(args.ws + WS_CTL);
    F.tid = threadIdx.x; F.lane = F.tid & 63; F.wave = __builtin_amdgcn_readfirstlane(F.tid >> 6); F.G = gridDim.x; F.bid = blockIdx.x;
    const int wave0 = F.wave, bid0 = F.bid, grid0 = F.G;
#define PHASE_TID() do { { int w_ = wave0, b_ = bid0, g_ = grid0; asm volatile("" : "+s"(w_), "+s"(b_), "+s"(g_)); F.wave = w_; F.bid = b_; F.G = g_; } F.lane = fresh_lane(); F.tid = F.wave * 64 + F.lane; unsigned long long w_ = (unsigned long long)ws0; asm volatile("" : "+s"(w_)); F.ws = (unsigned char*)(GAS unsigned char*)w_; ws = F.ws; F.ctl = (unsigned*)(F.ws + WS_CTL); } while (0)
    for (int u = F.tid; u < (LDS_BYTES - MISC_OFF) / 4; u += 512) ((LAS unsigned*)(F.lds + MISC_OFF))[u] = 0u;
    __syncthreads();
    XcdBarrier bar; bar.bar = F.ctl + CW_BAR; bar.x = 0; bar.st = nullptr; bar.wave = F.wave;
    if (N_LAUNCHES == 1) { bar = xcd_barrier_post(F.ctl + CW_BAR, (volatile LAS unsigned*)(F.lds + MISC_OFF + MO_BARW)); bar.wave = F.wave; }
    const int lo = args.ph_lo, hi = args.ph_hi;
#ifndef PHM
#define PHM 0x1ffff
#endif
#ifndef REPM
#define REPM 0
#endif
#define REP(j) for (int rep_ = 0; rep_ < (((REPM >> (j)) & 1) ? 2 : 1); ++rep_)
#define IN(k) (((PHM >> ((k) == 0 ? 0 : (k) < 9 ? (k) : (k) - 8 + 8)) & 1) && lo <= (k) && (k) < hi)
#define SEAM(k) do { if (IN(k) && IN((k) + 1)) xcd_barrier(bar); } while (0)
    unsigned char* const ws0 = args.ws; unsigned char* ws = ws0;
    if (IN(0)) REP(0) { PHASE_TID(); p0_prologue(F, args); }
    SEAM(0);
    for (int layer = 0; layer < 2; ++layer) {
        const int pb = 1 + 8 * layer;
        if (IN(pb)) REP(1) {
            PHASE_TID();
            const int N = layer ? N1 : N0;
            const int NW = layer ? F.G : F.G - NCONV;
            if (F.bid < NW) {
                pg8::DenseOrder S; S.init(ws + WS_XB, ws + (layer ? WS_WCIN : WS_WAIN), T, N, DM, NW, F.bid);
                EpiQKV E; E.out = (bf16_t*)(ws + WS_QKV); E.ldo = N; E.qrot = (bf16_t*)(ws + WS_QROT); E.rope128 = (const f32x4*)(ws + WS_ROPE128); E.rope64 = (const f32x4*)(ws + WS_ROPE64); E.layer = layer;
                pg8::gemm_phase<EpiQKV, pg8::DenseOrder>(F.lds, F.tid, 2 * DM, S, E);
            }
            if (layer == 0) {
                if (F.bid >= NW) {
                    cvt_pipeline(F, args, -1, 1, 0, 0, cvi::O1, cvi::O2, (F.bid - NW) * 8 + F.wave, NCONV * 8);
                    cvt_pipeline(F, args, -1, 1, 0, 0, cvi::O6, cvi::O7, (F.bid - NW) * 8 + F.wave, NCONV * 8);
                    pe_bias(F, args); }
                cvt_dynamic(F, args, 0, NW, F.bid < NW, false); }
        }
        SEAM(pb);
        if (IN(pb + 1)) REP(2) { PHASE_TID(); if (layer == 0) phase_kmean(F); else phase_compress(F); }
        SEAM(pb + 1);
        if (IN(pb + 2)) REP(3) { PHASE_TID();
            if (layer == 0) { const int NW = F.G - NCONV;
                if (F.bid < NW) { F.G = NW; phase_attn0(F, args); }
                cvt_dynamic(F, args, 1, NW, F.bid < NW, false); }
            else phase_attn1(F); }
        SEAM(pb + 2);
        if (IN(pb + 3)) REP(4) {
            PHASE_TID();
            pg8::DenseOrder S; S.init(ws + WS_ATT, ws + (layer ? WS_WCOUT : WS_WAOUT), T, DM, DM, F.G, F.bid);
            EpiRes E; E.res = (const bf16_t*)(ws + WS_XB); E.out = (bf16_t*)(ws + WS_Y1);
            pg8::gemm_phase<EpiRes, pg8::DenseOrder>(F.lds, F.tid, 2 * DM, S, E);
        }
        SEAM(pb + 3);
        if (IN(pb + 4)) { PHASE_TID(); if (layer == 0) cvt_dynamic(F, args, 0, 0, false, true); phase_ln_router(F, args, layer); }
        SEAM(pb + 4);
        if (IN(pb + 5)) REP(6) {
            PHASE_TID();
            const MoeTabs tb = build_moe_tabs(F, layer);
            GuOrder S; S.list = (const int*)(ws + WS_LIST); S.tb = tb; S.G = F.G; S.c = F.bid;
            S.A = (const char*)(ws + WS_HB8); S.W = (const char*)(ws + WS_WGU + (size_t)layer * 65 * WGU_E); S.RB = DM;
            EpiGU8 E; E.H = (bf16_t*)(ws + WS_HBUF); pg8::gemm_phase<EpiGU8, GuOrder, true>(F.lds, F.tid, DM, S, E);
        }
        SEAM(pb + 5);
        if (IN(pb + 6)) REP(7) {
            PHASE_TID();
            const MoeTabs tb = build_moe_tabs(F, layer);
            DnOrder S; S.H = (const char*)(ws + WS_HBUF); S.tb = tb; S.G = F.G; S.c = F.bid; S.W = (const char*)(ws + WS_WDN + (size_t)layer * 65 * WDN_E); S.RB = 2 * EDIM;
            EpiDN E; E.Y = (bf16_t*)(ws + WS_YBUF); pg8::gemm_phase<EpiDN, DnOrder, false>(F.lds, F.tid, 2 * EDIM, S, E);
        }
        SEAM(pb + 6);
        if (IN(pb + 7)) REP(8) { PHASE_TID(); const MoeTabs tb = build_moe_tabs(F, layer); phase_combine_ln(F, args, layer, tb); }
        SEAM(pb + 7);
    }
#undef IN
#undef SEAM
}

extern "C" void kernel_launch(void* const* d_in, const int* in_sizes, int n_in, void* d_out, int out_size, void* d_ws, size_t ws_size, hipStream_t stream) {
    static int grid = 0;
    if (grid == 0) {
        if (n_in != 26 || out_size != T * DM || ws_size < WS_END) { fprintf(stderr, "kernel_launch: unexpected problem (n_in %d, out %d, ws %zu < %zu)\n", n_in, out_size, ws_size, (size_t)WS_END); grid = -1; return; }
        int dev = 0, cus = 0, per_cu = 0;
        if (hipGetDevice(&dev) != hipSuccess || hipDeviceGetAttribute(&cus, hipDeviceAttributeMultiprocessorCount, dev) != hipSuccess) { grid = -1; return; }
        if (hipFuncSetAttribute((const void*)fwd, hipFuncAttributeMaxDynamicSharedMemorySize, LDS_BYTES) != hipSuccess) { fprintf(stderr, "kernel_launch: hipFuncSetAttribute failed\n"); grid = -1; return; }
        if (hipOccupancyMaxActiveBlocksPerMultiprocessor(&per_cu, (const void*)fwd, 512, LDS_BYTES) != hipSuccess || per_cu < 1) fprintf(stderr, "kernel_launch: occupancy query reports %d\n", per_cu);
        (void)hipGetLastError();
        grid = cus;
    }
    if (grid < 0) return;
    if (hipMemsetAsync((char*)d_ws + WS_CTL, 0, CTL_BYTES, stream) != hipSuccess) return;
    Args a{};
    for (int i = 0; i < 26; ++i) a.in[i] = (const float*)d_in[i];
    a.out = (float*)d_out; a.ws = (unsigned char*)d_ws;
    if (N_LAUNCHES == 1) { a.ph_lo = 0; a.ph_hi = NPHASE; hipLaunchKernelGGL(fwd, dim3(grid), dim3(512), LDS_BYTES, stream, a); }
    else { for (int p = 0; p < NPHASE; ++p) { a.ph_lo = p; a.ph_hi = p + 1; hipLaunchKernelGGL(fwd, dim3(grid), dim3(512), LDS_BYTES, stream, a); } }
}
```

```cpp
#include <hip/hip_runtime.h>
#include <cstdio>
#include <cstdint>

#ifndef MK_N_LAUNCHES
#define MK_N_LAUNCHES 1
#endif

#define LAS __attribute__((address_space(3)))
#define GAS __attribute__((address_space(1)))
typedef unsigned short bf16_t;
typedef short bf16x8 __attribute__((ext_vector_type(8)));
typedef short s16x4 __attribute__((ext_vector_type(4)));
typedef float f32x4 __attribute__((ext_vector_type(4)));
typedef float f32x2 __attribute__((ext_vector_type(2)));
typedef float f32x16 __attribute__((ext_vector_type(16)));
typedef unsigned u32x4 __attribute__((ext_vector_type(4)));
typedef unsigned u32x2 __attribute__((ext_vector_type(2)));
typedef int i32x8 __attribute__((ext_vector_type(8)));

constexpr int NB = 4, SEQ = 4096, T = NB * SEQ, DM = 2048;
constexpr int NEXP = 64, EDIM = 512, TOPK = 8, NGRP = 8, TOPKG = 4;
constexpr int N0 = 6144, N1 = 3840, N1R = 3632;
constexpr float DN_ALPHA = 1.41421356237309515f;
constexpr float LN_EPS = 1e-5f;
constexpr float NEGF = -1e30f;
constexpr float NEGS = -60000.0f;
constexpr int MAXTILES = 640;
constexpr int NPHASE = 17;

constexpr size_t al256(size_t x) { return (x + 255) & ~(size_t)255; }
constexpr size_t WS_CTL = 0, CTL_BYTES = 1u << 20, CTL_USED = 128u << 10;
constexpr size_t WS_ROPE128 = WS_CTL + CTL_BYTES;
constexpr size_t WS_ROPE64 = WS_ROPE128 + (size_t)SEQ * 64 * 8;
constexpr size_t WS_PEB = WS_ROPE64 + (size_t)SEQ * 32 * 8;
constexpr size_t WS_WAIN = WS_PEB + 4096;
constexpr size_t WS_WAOUT = WS_WAIN + (size_t)N0 * DM * 2;
constexpr size_t WS_WCIN = WS_WAOUT + (size_t)DM * DM * 2;
constexpr size_t WS_WCOUT = WS_WCIN + (size_t)N1 * DM * 2;
constexpr size_t WS_W1KT = WS_WCOUT + (size_t)DM * DM * 2;
constexpr size_t WS_W1VT = WS_W1KT + (size_t)128 * 4096 * 2;
constexpr size_t WS_W2KT = WS_W1VT + (size_t)128 * 4096 * 2;
constexpr size_t WS_W2VT = WS_W2KT + (size_t)128 * 128 * 2;
constexpr size_t WS_WRT = WS_W2VT + (size_t)128 * 128 * 2;
constexpr size_t WS_WGU = WS_WRT + (size_t)2 * 64 * DM * 2;
constexpr size_t WGU_E = (size_t)1024 * DM * 2;
constexpr size_t WS_WDN = WS_WGU + (size_t)2 * 65 * WGU_E;
constexpr size_t WDN_E = (size_t)DM * EDIM * 2;
constexpr size_t WS_XB = WS_WDN + (size_t)2 * 65 * WDN_E;
constexpr size_t WS_QKV = WS_XB + (size_t)T * DM * 2;
constexpr size_t WS_QROT = WS_QKV + (size_t)(T + 64) * N0 * 2;
constexpr size_t WS_KMEAN = WS_QROT + (size_t)T * DM * 2;
constexpr size_t WS_KCMP = WS_KMEAN + (size_t)NB * 8 * 32 * 128 * 2;
constexpr size_t WS_VCMP = WS_KCMP + (size_t)8 * 256 * 128 * 2;
constexpr size_t WS_ATT = WS_VCMP + (size_t)8 * 256 * 128 * 2;
constexpr size_t WS_Y1 = WS_ATT + (size_t)T * DM * 2;
constexpr size_t WS_STATS = WS_Y1 + (size_t)T * DM * 4;
constexpr size_t WS_HB = WS_STATS + (size_t)T * 8;
constexpr size_t WS_TOKE = WS_HB + (size_t)T * DM * 2;
constexpr size_t WS_TOKP = WS_TOKE + (size_t)T * 8 * 4;
constexpr size_t WS_TOKW = WS_TOKP + (size_t)T * 8 * 4;
constexpr size_t WS_LIST = WS_TOKW + (size_t)T * 8 * 4;
constexpr size_t WS_HBUF = WS_LIST + (size_t)NEXP * T * 4;
constexpr size_t WS_YBUF = WS_HBUF + (size_t)MAXTILES * 256 * EDIM * 2;
constexpr size_t WS_H2F = WS_YBUF + (size_t)MAXTILES * 256 * DM * 2;
constexpr size_t WS_HB8 = WS_H2F + (size_t)T * DM * 4;
constexpr size_t WS_END = WS_HB8 + (size_t)T * DM;
constexpr int CW_BAR = 4096;
constexpr int CW_QNEXT = 16384, CW_DONE = 16384 + 64;
constexpr int CW_CNT = 8192;

constexpr int RING_BYTES = 131072;
constexpr int MISC_OFF = RING_BYTES;
constexpr int LDS_BYTES = 147456;
constexpr int MO_BARW = 0;
constexpr int MO_TPRE = 64;
constexpr int MO_CNT = 64 + 66 * 4;
constexpr int MO_ETAB = 1024;
constexpr int MO_GEN = 2048;

#define LDS_WAIT() asm volatile("s_waitcnt lgkmcnt(0)" ::: "memory")
#define VM_WAIT() asm volatile("s_waitcnt vmcnt(0)" ::: "memory")
#define SBAR() __builtin_amdgcn_sched_barrier(0)
typedef __bf16 bf16x2_t __attribute__((ext_vector_type(2)));
__device__ __forceinline__ unsigned cvt_pk_bf16(float lo, float hi) { const f32x2 v = {lo, hi}; return __builtin_bit_cast(unsigned, __builtin_convertvector(v, bf16x2_t)); }
__device__ __forceinline__ unsigned pk_fp8x4(float a, float b, float c, float d) { int w = __builtin_amdgcn_cvt_pk_fp8_f32(a, b, 0, false); w = __builtin_amdgcn_cvt_pk_fp8_f32(c, d, w, true); return (unsigned)w; }
constexpr float F8_WSCALE = 64.0f, F8_HSCALE = 16.0f, F8_YSCALE = 16.0f;
__device__ __forceinline__ float bf2f(unsigned short b) { return __uint_as_float(((unsigned)b) << 16); }
__device__ __forceinline__ float bflo(unsigned w) { return __uint_as_float(w << 16); }
__device__ __forceinline__ float bfhi(unsigned w) { return __uint_as_float(w & 0xffff0000u); }
template <int K> __device__ __forceinline__ float swz_xor(float v) { return __int_as_float(__builtin_amdgcn_ds_swizzle(__float_as_int(v), (K << 10) | 0x1f)); }
struct F2 { float own_lo, own_hi; };
__device__ __forceinline__ float sum32(float v) { auto r = __builtin_amdgcn_permlane32_swap(__float_as_uint(v), __float_as_uint(v), false, false); return __uint_as_float(r[0]) + __uint_as_float(r[1]); }
__device__ __forceinline__ float max32(float v) { auto r = __builtin_amdgcn_permlane32_swap(__float_as_uint(v), __float_as_uint(v), false, false); return fmaxf(__uint_as_float(r[0]), __uint_as_float(r[1])); }
__device__ __forceinline__ float partner32(float v, int h) { auto r = __builtin_amdgcn_permlane32_swap(__float_as_uint(v), __float_as_uint(v), false, false); return __uint_as_float(h ? r[0] : r[1]); }
__device__ __forceinline__ float wave_sum(float v) {
    v += swz_xor<1>(v); v += swz_xor<2>(v); v += swz_xor<4>(v); v += swz_xor<8>(v); v += swz_xor<16>(v);
    return sum32(v);
}
__device__ __forceinline__ float fast_exp2(float x) { return __builtin_amdgcn_exp2f(x); }
__device__ __forceinline__ float fast_rcp(float x) { return __builtin_amdgcn_rcpf(x); }

__device__ __forceinline__ int fresh_lane() { int l; asm volatile("v_mbcnt_lo_u32_b32 %0, -1, 0\n\tv_mbcnt_hi_u32_b32 %0, -1, %0" : "=v"(l)); return l; }
#define XB_TMO      128
#define XB_XCNT(j)  (256  + 64 * (j))
#define XB_XSUB(j)  (1280 + 64 * (j))
#define XB_XGEN(j)  (2304 + 64 * (j))
#define XB_TOP      3328
#define XB_TOPGEN   3392
#define XCD_BAR_WORDS 3456
#define XB_SPIN_CAP (1u << 21)
__device__ __forceinline__ unsigned xb_ld(unsigned* p)              { return __hip_atomic_load(p, __ATOMIC_RELAXED, __HIP_MEMORY_SCOPE_AGENT); }
__device__ __forceinline__ unsigned xb_add(unsigned* p, unsigned v) { return __hip_atomic_fetch_add(p, v, __ATOMIC_RELAXED, __HIP_MEMORY_SCOPE_AGENT); }
__device__ __forceinline__ unsigned xb_xcc_id() { return (unsigned)__builtin_amdgcn_s_getreg((3 << 11) | 20) & 0xFu; }
#define XB_SPIN(cond, bar) do { unsigned _sp = 0; while (cond) { __builtin_amdgcn_s_sleep(1); \
    if ((++_sp & 255u) == 0u) { if (xb_ld(&(bar)[XB_TMO])) break; if (_sp > XB_SPIN_CAP) { atomicAdd(&(bar)[XB_TMO], 1u); break; } } } } while (0)
struct XcdBarrier { unsigned* bar; unsigned x; volatile LAS unsigned* st; int wave; };
__device__ __forceinline__ XcdBarrier xcd_barrier_post(unsigned* bar, volatile LAS unsigned* st) {
    XcdBarrier b; b.bar = bar; b.x = xb_xcc_id(); b.st = st; b.wave = 0;
    if (threadIdx.x == 0) (void)xb_add(&bar[XB_XCNT(b.x)], 1u);
    return b;
}
__device__ __forceinline__ void xcd_barrier_complete(unsigned* bar, unsigned x, unsigned& nloc, unsigned& nx) {
    const unsigned G = gridDim.x * gridDim.y * gridDim.z;
    unsigned sum, cnt, mine, sp = 0u;
    for (;;) {
        sum = 0u; cnt = 0u; mine = 0u;
#pragma unroll
        for (unsigned j = 0; j < 16; ++j) { const unsigned c = xb_ld(&bar[XB_XCNT(j)]); sum += c; cnt += (c > 0u) ? 1u : 0u; mine = (j == x) ? c : mine; }
        if (sum == G) break;
        __builtin_amdgcn_s_sleep(1);
        if ((++sp & 255u) == 0u) { if (xb_ld(&bar[XB_TMO])) break; if (sp > XB_SPIN_CAP) { atomicAdd(&bar[XB_TMO], 1u); break; } }
    }
    nloc = mine > 0u ? mine : 1u; nx = cnt > 0u ? cnt : 1u;
}
__device__ __forceinline__ void xcd_barrier(const XcdBarrier& b) {
    asm volatile("s_waitcnt vmcnt(0)" ::: "memory");
    __syncthreads();
    if (b.wave == 0 && fresh_lane() == 0) {
        unsigned long long bar_ = (unsigned long long)b.bar; asm volatile("" : "+s"(bar_));
        unsigned* bar = (unsigned*)(GAS unsigned*)bar_;
        __builtin_amdgcn_s_waitcnt(0);
        unsigned nloc = b.st[0], nx = b.st[1];
        if (nloc == 0u) { xcd_barrier_complete(bar, b.x, nloc, nx); b.st[0] = nloc; b.st[1] = nx; }
        const unsigned old = xb_add(&bar[XB_XSUB(b.x)], 1u);
        const unsigned gen = old / nloc;
        if (old + 1u == (gen + 1u) * nloc) {
            __builtin_amdgcn_fence(__ATOMIC_RELEASE, "agent");
            asm volatile("s_waitcnt vmcnt(0)" ::: "memory");
            const unsigned og = xb_add(&bar[XB_TOP], 1u);
            const unsigned tg = og / nx;
            if (og + 1u == (tg + 1u) * nx) xb_add(&bar[XB_TOPGEN], 1u);
            else XB_SPIN(xb_ld(&bar[XB_TOPGEN]) == tg, bar);
            __builtin_amdgcn_fence(__ATOMIC_ACQUIRE, "agent");
            xb_add(&bar[XB_XGEN(b.x)], 1u);
            asm volatile("s_waitcnt vmcnt(0)" ::: "memory");
        } else {
            XB_SPIN(xb_ld(&bar[XB_XGEN(b.x)]) == gen, bar);
            __builtin_amdgcn_fence(__ATOMIC_ACQUIRE, "agent");
            asm volatile("s_waitcnt vmcnt(0)" ::: "memory");
        }
    }
    __syncthreads();
}
__device__ __forceinline__ void wg_self_visible(int wave) {
    asm volatile("s_waitcnt vmcnt(0)" ::: "memory");
    __syncthreads();
    if (wave == 0 && fresh_lane() == 0) { __builtin_amdgcn_fence(__ATOMIC_ACQUIRE, "agent"); asm volatile("s_waitcnt vmcnt(0)" ::: "memory"); }
    __syncthreads();
}

enum { MAP_ID = 0, MAP_PLAIN = 1, MAP_R128 = 2, MAP_R64 = 3 };
__host__ __device__ __forceinline__ int map_col(int type, int p) {
    const int wc = p >> 5, n = (p >> 4) & 1, fq = (p >> 2) & 3, e = p & 3;
    if (type == MAP_PLAIN) return 32 * wc + 8 * fq + 4 * n + e;
    if (type == MAP_R128) return 64 * n + 16 * wc + 4 * fq + e;
    if (type == MAP_R64) return 64 * (wc >> 1) + 32 * n + 16 * (wc & 1) + 4 * fq + e;
    return p;
}
enum { HT_PLAIN = 0, HT_R128 = 1, HT_R64 = 2, HT_RQ = 3, HT_SKIP = 4 };
__host__ __device__ __forceinline__ int ht_type(int layer, int ht) {
    if (layer == 0) { const int g = ht >> 3; return (g == 0 || g == 1) ? HT_R64 : ((g == 3 || g == 4) ? HT_R128 : HT_PLAIN); }
    if (ht < 16) return HT_RQ;
    if (ht == 20 || ht == 21 || ht == 24 || ht == 25) return HT_R128;
    if (ht == 29) return HT_SKIP;
    return HT_PLAIN;
}
__host__ __device__ __forceinline__ int ht_map(int t) { return t == HT_PLAIN || t == HT_SKIP ? MAP_PLAIN : (t == HT_R64 ? MAP_R64 : MAP_R128); }

namespace pg8 {
constexpr int BM = 256, BK = 64, HALF = 128, HTB = HALF * BK * 2, STAGE_BYTES = 8 * HTB, NXCD = 8, WGM = 8;
__host__ __device__ __forceinline__ int lds_byte(int r, int c) { const int st = (r >> 4) * 2 + (c >> 5), rr = r & 15, cc = c & 31, ob = rr * 64 + cc * 2; return st * 1024 + (ob ^ (((ob >> 9) & 1) << 5)); }
__host__ __device__ __forceinline__ void stage_rc(int b, int& R, int& C) { const int st = b / 1024, sb = b % 1024, swz = sb ^ (((sb >> 9) & 1) << 5); R = (st >> 1) * 16 + swz / 64; C = (st & 1) * 32 + (swz % 64) / 2; }

struct Unit { int pm, pn; const char* a; const char* b; int e, gt; };

struct DenseOrder {
    static constexpr bool PER_UNIT_OFFS = false;
    const char* A; const char* Bt; int RB, nM, nN, nwg, G, c;
    __device__ __forceinline__ void init(const void* A_, const void* Bt_, int M, int N, int K_, int G_, int c_) { A = (const char*)A_; Bt = (const char*)Bt_; RB = 2 * K_; nM = M / BM; nN = N / BM; nwg = nM * nN; G = G_; c = c_; }
    __device__ __forceinline__ bool next(int i, Unit& u) const {
        const long L = (long)i * G + c; if (L >= nwg) return false;
        int wgid = (int)L; { const int q = nwg / NXCD, r = nwg % NXCD, xcd = wgid % NXCD, off = wgid / NXCD; wgid = (xcd < r ? xcd * (q + 1) : r * (q + 1) + (xcd - r) * q) + off; }
        const int nig = WGM * nN, gid = wgid / nig, fm = gid * WGM, gsz = (nM - fm) < WGM ? (nM - fm) : WGM;
        u.pm = fm + ((wgid % nig) % gsz); u.pn = (wgid % nig) / gsz; u.e = 0; u.gt = u.pm;
        u.a = A + (size_t)u.pm * BM * RB; u.b = Bt + (size_t)u.pn * BM * RB; return true;
    }
    __device__ __forceinline__ void aoffs(const Unit&, const int (&R)[2], const int (&C)[2], unsigned (&v0)[2], unsigned (&v1)[2]) const {
#pragma unroll
        for (int i = 0; i < 2; ++i) { v0[i] = (unsigned)(R[i] * RB + 2 * C[i]); v1[i] = v0[i] + (unsigned)(HALF * RB); }
    }
};

template <class Epi, class Sched, bool FP8 = false>
__device__ __forceinline__ void gemm_phase(LAS unsigned char* lds, const int tid, const int RB  , const Sched& S, const Epi& E) {
    const int wid = __builtin_amdgcn_readfirstlane(tid >> 6), lane = tid & 63, wr = wid >> 2, wc = wid & 3, fr = lane & 15, fq = lane >> 4;
    const int nt = RB / 128;
    int sR[2], sC[2]; unsigned voffB[2];
#pragma unroll
    for (int i = 0; i < 2; ++i) { stage_rc(tid * 16 + i * 8192, sR[i], sC[i]); voffB[i] = (unsigned)(sR[i] * RB + 2 * sC[i]); }
    const size_t kstep = (size_t)(BK * 2);
    const size_t hstep = (size_t)HALF * RB;
    const unsigned ldsw = (unsigned)wid * 1024u;
    const int fcol = FP8 ? 32 * (fq >> 1) + 16 * (fq & 1) : fq * 8;
    const int aoff = lds_byte(wr * 64 + fr, fcol), boff = lds_byte(wc * 32 + fr, fcol);
#define PG8_SA(b, h) (((b) * 2 + (h)) * HTB)
#define PG8_SB(b, h) ((4 + (b) * 2 + (h)) * HTB)
#define PG8_STAGE(bufoff, gbase, voff) do { _Pragma("unroll") for (int _i = 0; _i < 2; ++_i) \
        __builtin_amdgcn_global_load_lds((const unsigned*)((const char*)(gbase) + (voff)[_i]), (LAS unsigned*)(lds + (bufoff) + ldsw + _i * 8192), 16, 0, 0); } while (0)
#define PG8_LDA(dst, b, h) do { _Pragma("unroll") for (int m = 0; m < 4; ++m) { if constexpr (FP8) dst##8[m] = *(const LAS i32x8*)(lds + PG8_SA(b, h) + aoff + m * 2048); else { _Pragma("unroll") for (int k = 0; k < 2; ++k) dst[m][k] = *(const LAS u32x4*)(lds + PG8_SA(b, h) + aoff + m * 2048 + k * 1024); } } } while (0)
#define PG8_LDB(dst, b, h) do { _Pragma("unroll") for (int n = 0; n < 2; ++n) { if constexpr (FP8) dst##8[n] = *(const LAS i32x8*)(lds + PG8_SB(b, h) + boff + n * 2048); else { _Pragma("unroll") for (int k = 0; k < 2; ++k) dst[n][k] = *(const LAS u32x4*)(lds + PG8_SB(b, h) + boff + n * 2048 + k * 1024); } } } while (0)
#define PG8_CAT(x) __builtin_shufflevector(__builtin_bit_cast(i32x4_t, (x)[0]), __builtin_bit_cast(i32x4_t, (x)[1]), 0, 1, 2, 3, 4, 5, 6, 7)
#define PG8_MMA(ai, bj, At, Bt) do { __builtin_amdgcn_s_setprio(1); _Pragma("unroll") for (int m = 0; m < 4; ++m) _Pragma("unroll") for (int n = 0; n < 2; ++n) { \
        if constexpr (FP8) acc[ai][bj][m][n] = __builtin_amdgcn_mfma_scale_f32_16x16x128_f8f6f4(Bt##8[n], At##8[m], acc[ai][bj][m][n], 0, 0, 0, 0x7f7f7f7f, 0, 0x7f7f7f7f); \
        else { _Pragma("unroll") for (int k = 0; k < 2; ++k) acc[ai][bj][m][n] = __builtin_amdgcn_mfma_f32_16x16x32_bf16(__builtin_bit_cast(bf16x8, Bt[n][k]), __builtin_bit_cast(bf16x8, At[m][k]), acc[ai][bj][m][n], 0, 0, 0); } } \
        __builtin_amdgcn_s_setprio(0); } while (0)
#define PG8_WAIT_V(n) asm volatile("s_waitcnt vmcnt(" #n ")" ::: "memory")
#define PG8_WAIT_L(n) asm volatile("s_waitcnt lgkmcnt(" #n ")" ::: "memory")
#define PG8_BAR __builtin_amdgcn_s_barrier()
#define PG8_SCHED __builtin_amdgcn_sched_barrier(0)
    Unit cur, nxt; int ui = 0;
    if (!S.next(0, cur)) return;
    f32x4 acc[2][2][4][2];
#pragma unroll
    for (int a = 0; a < 2; ++a)
#pragma unroll
        for (int b = 0; b < 2; ++b)
#pragma unroll
            for (int m = 0; m < 4; ++m)
#pragma unroll
                for (int n = 0; n < 2; ++n) acc[a][b][m][n] = (f32x4){0.f, 0.f, 0.f, 0.f};
    typedef int i32x4_t __attribute__((ext_vector_type(4)));
    u32x4 At[4][2], B0[2][2], B1[2][2]; i32x8 At8[4], B08[2], B18[2];
    unsigned vA0[2], vA1[2], nA0[2], nA1[2];
    S.aoffs(cur, sR, sC, vA0, vA1);
    const char* cA = cur.a; const char* cB = cur.b;
    PG8_STAGE(PG8_SB(0, 0), cB, voffB); PG8_STAGE(PG8_SA(0, 0), cA, vA0); PG8_STAGE(PG8_SB(0, 1), cB + hstep, voffB); PG8_STAGE(PG8_SA(0, 1), cA, vA1);
    if (wr == 1) PG8_BAR;
    PG8_WAIT_V(4); PG8_BAR;
    PG8_STAGE(PG8_SB(1, 0), cB + kstep, voffB); PG8_STAGE(PG8_SA(1, 0), cA + kstep, vA0); PG8_STAGE(PG8_SB(1, 1), cB + hstep + kstep, voffB);
    PG8_WAIT_V(6); PG8_BAR;
    Unit nn = cur; bool has_next = S.next(1, nxt); unsigned pA0[2], pA1[2];
    if constexpr (Sched::PER_UNIT_OFFS) {
        if (has_next) S.aoffs(nxt, sR, sC, nA0, nA1); else { nA0[0] = vA0[0]; nA0[1] = vA0[1]; nA1[0] = vA1[0]; nA1[1] = vA1[1]; }
        asm volatile("" : "+v"(nA0[0]), "+v"(nA0[1]), "+v"(nA1[0]), "+v"(nA1[1]));
    }
    for (;;) {
        if constexpr (!Sched::PER_UNIT_OFFS) { if (ui > 0) has_next = S.next(ui + 1, nxt); }
        const char* nA = has_next ? nxt.a : cA; const char* nB = has_next ? nxt.b : cB;
        for (int t = 0; t < nt; t += 2) {
            const bool last = (t == nt - 2);
            const char* a1 = cA + (size_t)(t + 1) * kstep;
            const char* a2 = last ? nA : cA + (size_t)(t + 2) * kstep; const char* b2 = last ? nB : cB + (size_t)(t + 2) * kstep;
            const char* a3 = a2 + kstep; const char* b3 = b2 + kstep;
            PG8_LDB(B0, 0, 0); PG8_SCHED; PG8_LDA(At, 0, 0); PG8_STAGE(PG8_SA(1, 1), a1, vA1);
            if constexpr (Sched::PER_UNIT_OFFS) { if (last) { vA0[0] = nA0[0]; vA0[1] = nA0[1]; vA1[0] = nA1[0]; vA1[1] = nA1[1]; } }
            PG8_WAIT_L(8); PG8_BAR; PG8_WAIT_L(0); PG8_MMA(0, 0, At, B0); PG8_BAR; PG8_SCHED;
            PG8_LDB(B1, 0, 1); PG8_STAGE(PG8_SB(0, 0), b2, voffB);
            PG8_BAR; PG8_WAIT_L(0); PG8_MMA(0, 1, At, B1); PG8_BAR;
            PG8_LDA(At, 0, 1); PG8_STAGE(PG8_SA(0, 0), a2, vA0);
            PG8_BAR; PG8_WAIT_L(0); PG8_MMA(1, 0, At, B0); PG8_BAR; PG8_SCHED;
            PG8_STAGE(PG8_SB(0, 1), b2 + hstep, voffB);
            PG8_WAIT_V(6); PG8_BAR; PG8_MMA(1, 1, At, B1); PG8_BAR;
            PG8_LDB(B0, 1, 0); PG8_SCHED; PG8_LDA(At, 1, 0); PG8_STAGE(PG8_SA(0, 1), a2, vA1);
            PG8_WAIT_L(8); PG8_BAR; PG8_WAIT_L(0); PG8_MMA(0, 0, At, B0); PG8_BAR; PG8_SCHED;
            PG8_LDB(B1, 1, 1); PG8_STAGE(PG8_SB(1, 0), b3, voffB);
            PG8_BAR; PG8_WAIT_L(0); PG8_MMA(0, 1, At, B1); PG8_BAR;
            PG8_LDA(At, 1, 1); PG8_STAGE(PG8_SA(1, 0), a3, vA0);
            PG8_BAR; PG8_WAIT_L(0); PG8_MMA(1, 0, At, B0); PG8_BAR; PG8_SCHED;
            PG8_STAGE(PG8_SB(1, 1), b3 + hstep, voffB);
            PG8_WAIT_V(6); PG8_BAR; PG8_MMA(1, 1, At, B1); PG8_BAR;
        }
        bool has_nn = false;
        if constexpr (Sched::PER_UNIT_OFFS) {
            has_nn = has_next && S.next(ui + 2, nn);
            if (has_nn) S.aoffs(nn, sR, sC, pA0, pA1); else { pA0[0] = nA0[0]; pA0[1] = nA0[1]; pA1[0] = nA1[0]; pA1[1] = nA1[1]; }
        }
        E(acc, cur, wr, wc, fr, fq);
        if (!has_next) break;
        if constexpr (Sched::PER_UNIT_OFFS) {
            asm volatile("" : "+v"(pA0[0]), "+v"(pA0[1]), "+v"(pA1[0]), "+v"(pA1[1]));
            nA0[0] = pA0[0]; nA0[1] = pA0[1]; nA1[0] = pA1[0]; nA1[1] = pA1[1];
        }
#pragma unroll
        for (int a = 0; a < 2; ++a)
#pragma unroll
            for (int b = 0; b < 2; ++b)
#pragma unroll
                for (int m = 0; m < 4; ++m)
#pragma unroll
                    for (int n = 0; n < 2; ++n) acc[a][b][m][n] = (f32x4){0.f, 0.f, 0.f, 0.f};
        cur = nxt; cA = nA; cB = nB; ++ui;
        if constexpr (Sched::PER_UNIT_OFFS) { nxt = nn; has_next = has_nn; }
    }
    PG8_WAIT_V(0);
    if (wr == 0) PG8_BAR;
    PG8_BAR;
#undef PG8_SA
#undef PG8_SB
#undef PG8_STAGE
#undef PG8_LDA
#undef PG8_LDB
#undef PG8_MMA
#undef PG8_WAIT_V
#undef PG8_WAIT_L
#undef PG8_BAR
#undef PG8_SCHED
}
}

struct MoeTabs { LAS const int* tpre; LAS const int* cnt; LAS const unsigned char* etab; int ntiles; };
__device__ __forceinline__ int xcd_remap(int L, int n) { constexpr int NXCD = pg8::NXCD; const int q = n / NXCD, r = n % NXCD, xcd = L % NXCD, off = L / NXCD; return (xcd < r ? xcd * (q + 1) : r * (q + 1) + (xcd - r) * q) + off; }
struct GuOrder {
    static constexpr bool PER_UNIT_OFFS = true;
    const char* A; const char* W; const int* list; MoeTabs tb; int G, c, RB;
    __device__ __forceinline__ bool next(int i, pg8::Unit& u) const {
        const long L0 = (long)i * G + c; const int nu = tb.ntiles * 4; if (L0 >= (long)nu) return false;
        const int L = xcd_remap((int)L0, nu);
        const int gt = (int)(L >> 2), pn = (int)(L & 3), e = __builtin_amdgcn_readfirstlane((int)tb.etab[gt]);
        u.gt = gt; u.e = e; u.pn = pn; u.pm = gt - __builtin_amdgcn_readfirstlane(tb.tpre[e]); u.a = A; u.b = W + (size_t)e * 1024 * RB + (size_t)pn * 256 * RB; return true;
    }
    __device__ __forceinline__ void aoffs(const pg8::Unit& u, const int (&R)[2], const int (&C)[2], unsigned (&v0)[2], unsigned (&v1)[2]) const {
        const int n = __builtin_amdgcn_readfirstlane(tb.cnt[u.e]);
#pragma unroll
        for (int i = 0; i < 2; ++i) {
            const int r0 = u.pm * 256 + R[i], r1 = r0 + 128;
            int t0 = 0, t1 = 0;
            if (u.e == NEXP) { t0 = r0; t1 = r1; }
            else { if (r0 < n) t0 = list[(size_t)u.e * T + r0]; if (r1 < n) t1 = list[(size_t)u.e * T + r1]; }
            v0[i] = (unsigned)(t0 * RB + 2 * C[i]); v1[i] = (unsigned)(t1 * RB + 2 * C[i]);
        }
    }
};
struct DnOrder {
    static constexpr bool PER_UNIT_OFFS = false;
    const char* H; const char* W; MoeTabs tb; int G, c, RB;
    __device__ __forceinline__ bool next(int i, pg8::Unit& u) const {
        const long L0 = (long)i * G + c; const int nu = tb.ntiles * 8; if (L0 >= (long)nu) return false;
        const int L = xcd_remap((int)L0, nu);
        const int gt = (int)(L >> 3), pn = (int)(L & 7), e = __builtin_amdgcn_readfirstlane((int)tb.etab[gt]);
        u.gt = gt; u.e = e; u.pn = pn; u.pm = gt; u.a = H + (size_t)gt * 256 * RB; u.b = W + (size_t)e * DM * RB + (size_t)pn * 256 * RB; return true;
    }
    __device__ __forceinline__ void aoffs(const pg8::Unit&, const int (&R)[2], const int (&C)[2], unsigned (&v0)[2], unsigned (&v1)[2]) const {
#pragma unroll
        for (int i = 0; i < 2; ++i) { v0[i] = (unsigned)(R[i] * RB + 2 * C[i]); v1[i] = v0[i] + (unsigned)(128 * RB); }
    }
};

__device__ __forceinline__ void pair_swap(u32x2& a, u32x2& b) {
    auto r0 = __builtin_amdgcn_permlane16_swap(a.x, b.x, false, false); a.x = r0[0]; b.x = r0[1];
    auto r1 = __builtin_amdgcn_permlane16_swap(a.y, b.y, false, false); a.y = r1[0]; b.y = r1[1];
}
struct EpiQKV {
    bf16_t* out; int ldo; bf16_t* qrot; const f32x4* rope128; const f32x4* rope64; int layer;
    template <int TYPE>
    __device__ __forceinline__ void half(const f32x4 (&acc)[2][2][4][2], const pg8::Unit& u, int bj, int ht, int wr, int wc, int fr, int fq) const {
        unsigned char* ob = (unsigned char*)out; unsigned char* qb = (unsigned char*)qrot; const unsigned char* r64 = (const unsigned char*)rope64; const unsigned char* r128 = (const unsigned char*)rope128;
#pragma unroll
        for (int ai = 0; ai < 2; ++ai) {
          f32x4 csa[4], csb[4];
          if constexpr (TYPE != HT_PLAIN) {
#pragma unroll
            for (int m = 0; m < 4; ++m) { const int row = u.pm * 256 + ai * 128 + wr * 64 + m * 16 + fr, pos = row & (SEQ - 1);
                if constexpr (TYPE == HT_R64) { const int i0 = 16 * (wc & 1) + 4 * fq; const unsigned o = (unsigned)((pos * 32 + i0) >> 1) * 16u; csa[m] = *(const f32x4*)(r64 + o); csb[m] = *(const f32x4*)(r64 + o + 16u); }
                else { const int i0 = 16 * wc + 4 * fq; const unsigned o = (unsigned)((pos * 64 + i0) >> 1) * 16u; csa[m] = *(const f32x4*)(r128 + o); csb[m] = *(const f32x4*)(r128 + o + 16u); } }
          }
#pragma unroll
            for (int m = 0; m < 4; ++m) {
                const int row = u.pm * 256 + ai * 128 + wr * 64 + m * 16 + fr;
                const f32x4 v0 = bj ? acc[ai][1][m][0] : acc[ai][0][m][0], v1 = bj ? acc[ai][1][m][1] : acc[ai][0][m][1];
                const unsigned oo = (unsigned)row * (unsigned)ldo * 2u + 256u * (unsigned)ht;
                if constexpr (TYPE == HT_PLAIN) {
                    u32x4 w; w.x = cvt_pk_bf16(v0[0], v0[1]); w.y = cvt_pk_bf16(v0[2], v0[3]); w.z = cvt_pk_bf16(v1[0], v1[1]); w.w = cvt_pk_bf16(v1[2], v1[3]);
                    *(u32x4*)(ob + oo + 2u * (unsigned)(32 * wc + 8 * fq)) = w;
                } else {
                    const f32x4 ca = csa[m], cb = csb[m];
                    const float y10 = v0[0] * ca[0] - v1[0] * ca[1], y20 = v1[0] * ca[0] + v0[0] * ca[1];
                    const float y11 = v0[1] * ca[2] - v1[1] * ca[3], y21 = v1[1] * ca[2] + v0[1] * ca[3];
                    const float y12 = v0[2] * cb[0] - v1[2] * cb[1], y22 = v1[2] * cb[0] + v0[2] * cb[1];
                    const float y13 = v0[3] * cb[2] - v1[3] * cb[3], y23 = v1[3] * cb[2] + v0[3] * cb[3];
                    u32x2 a, b; a.x = cvt_pk_bf16(y10, y11); a.y = cvt_pk_bf16(y12, y13); b.x = cvt_pk_bf16(y20, y21); b.y = cvt_pk_bf16(y22, y23);
                    pair_swap(a, b);
                    const unsigned odd = (unsigned)(fq & 1);
                    if constexpr (TYPE == HT_R64) { const int i0 = 16 * (wc & 1) + 4 * fq; const unsigned d = oo + 2u * (unsigned)(64 * (wc >> 1) + i0) + odd * 56u; *(u32x4*)(ob + d) = (u32x4){a.x, a.y, b.x, b.y}; }
                    else { const int i0 = 16 * wc + 4 * fq;
                        if constexpr (TYPE == HT_RQ) {
                            const unsigned d = (unsigned)row * (unsigned)(DM * 2) + 2u * (unsigned)(128 * ht + i0) + odd * 120u;
                            *(u32x4*)(qb + d) = (u32x4){a.x, a.y, b.x, b.y};
                            u32x2 c, e; c.x = cvt_pk_bf16(v0[0], v0[1]); c.y = cvt_pk_bf16(v0[2], v0[3]); e.x = cvt_pk_bf16(v1[0], v1[1]); e.y = cvt_pk_bf16(v1[2], v1[3]);
                            pair_swap(c, e);
                            *(u32x4*)(ob + oo + 2u * (unsigned)i0 + odd * 120u) = (u32x4){c.x, c.y, e.x, e.y};
                        } else { *(u32x4*)(ob + oo + 2u * (unsigned)i0 + odd * 120u) = (u32x4){a.x, a.y, b.x, b.y}; } }
                }
            }
          asm volatile("" ::: "memory");
        }
    }
    __device__ __forceinline__ void operator()(const f32x4 (&acc)[2][2][4][2], const pg8::Unit& u, int wr, int wc, int fr, int fq) const {
        asm volatile("" : "+v"(fr), "+v"(fq));
#pragma unroll
        for (int bj = 0; bj < 2; ++bj) {
            const int ht = 2 * u.pn + bj, type = ht_type(layer, ht);
            if (type == HT_SKIP) continue;
            if (type == HT_PLAIN) half<HT_PLAIN>(acc, u, bj, ht, wr, wc, fr, fq);
            else if (type == HT_R64) half<HT_R64>(acc, u, bj, ht, wr, wc, fr, fq);
            else if (type == HT_RQ) half<HT_RQ>(acc, u, bj, ht, wr, wc, fr, fq);
            else half<HT_R128>(acc, u, bj, ht, wr, wc, fr, fq);
            asm volatile("" ::: "memory");
        }
    }
};
struct EpiRes {
    const bf16_t* res; bf16_t* out;
    __device__ __forceinline__ void operator()(const f32x4 (&acc)[2][2][4][2], const pg8::Unit& u, int wr, int wc, int fr, int fq) const {
        asm volatile("" : "+v"(fr), "+v"(fq));
        const int row0 = u.pm * 256 + wr * 64 + fr, col0 = u.pn * 256 + wc * 32 + 8 * fq;
        u32x4 q[2][4][2];
#pragma unroll
        for (int ai = 0; ai < 2; ++ai)
#pragma unroll
            for (int m = 0; m < 4; ++m)
#pragma unroll
                for (int bj = 0; bj < 2; ++bj) q[ai][m][bj] = *(const u32x4*)(res + (size_t)(row0 + ai * 128 + m * 16) * DM + col0 + bj * 128);
#pragma unroll
        for (int ai = 0; ai < 2; ++ai)
#pragma unroll
            for (int m = 0; m < 4; ++m) { const size_t off = (size_t)(row0 + ai * 128 + m * 16) * DM + col0;
#pragma unroll
                for (int bj = 0; bj < 2; ++bj) { const u32x4 qq = q[ai][m][bj]; const f32x4 v0 = acc[ai][bj][m][0], v1 = acc[ai][bj][m][1];
                    u32x4 w; w.x = cvt_pk_bf16(bflo(qq.x) * DN_ALPHA + v0[0], bfhi(qq.x) * DN_ALPHA + v0[1]); w.y = cvt_pk_bf16(bflo(qq.y) * DN_ALPHA + v0[2], bfhi(qq.y) * DN_ALPHA + v0[3]);
                    w.z = cvt_pk_bf16(bflo(qq.z) * DN_ALPHA + v1[0], bfhi(qq.z) * DN_ALPHA + v1[1]); w.w = cvt_pk_bf16(bflo(qq.w) * DN_ALPHA + v1[2], bfhi(qq.w) * DN_ALPHA + v1[3]);
                    *(u32x4*)(out + off + bj * 128) = w; } }
    }
};
__device__ __forceinline__ float silu_f(float x) { return x * fast_rcp(1.0f + fast_exp2(-1.44269504089f * x)); }
template <bool F8> struct EpiGU_ {
    bf16_t* H;
    __device__ __forceinline__ void operator()(const f32x4 (&acc)[2][2][4][2], const pg8::Unit& u, int wr, int wc, int fr, int fq) const {
        asm volatile("" : "+v"(fr), "+v"(fq));
#pragma unroll
        for (int ai = 0; ai < 2; ++ai)
#pragma unroll
            for (int m = 0; m < 4; ++m) {
                const size_t row = (size_t)u.gt * 256 + ai * 128 + wr * 64 + m * 16 + fr;
                const f32x4 g0 = acc[ai][0][m][0], g1 = acc[ai][0][m][1], u0 = acc[ai][1][m][0], u1 = acc[ai][1][m][1];
                constexpr float si = F8 ? 1.0f / F8_WSCALE : 1.0f;
                const f32x4 a0 = g0 * si, a1 = g1 * si, b0 = u0 * si, b1 = u1 * si;
                u32x4 w;
                w.x = cvt_pk_bf16(silu_f(a0[0]) * b0[0], silu_f(a0[1]) * b0[1]); w.y = cvt_pk_bf16(silu_f(a0[2]) * b0[2], silu_f(a0[3]) * b0[3]);
                w.z = cvt_pk_bf16(silu_f(a1[0]) * b1[0], silu_f(a1[1]) * b1[1]); w.w = cvt_pk_bf16(silu_f(a1[2]) * b1[2], silu_f(a1[3]) * b1[3]);
                *(u32x4*)(H + row * EDIM + 128 * u.pn + 32 * wc + 8 * fq) = w;
                asm volatile("" ::: "memory");
            }
    }
};
typedef EpiGU_<false> EpiGU; typedef EpiGU_<true> EpiGU8;
template <bool F8> struct EpiDN_ {
    bf16_t* Y;
    __device__ __forceinline__ void operator()(const f32x4 (&acc)[2][2][4][2], const pg8::Unit& u, int wr, int wc, int fr, int fq) const {
        asm volatile("" : "+v"(fr), "+v"(fq));
#pragma unroll
        for (int ai = 0; ai < 2; ++ai)
#pragma unroll
            for (int m = 0; m < 4; ++m) {
                const size_t row = (size_t)u.gt * 256 + ai * 128 + wr * 64 + m * 16 + fr;
                constexpr float sc = (F8 ? 1.0f / (F8_WSCALE * F8_HSCALE) : 1.0f) * F8_YSCALE;
                const f32x4 v0 = acc[ai][0][m][0] * sc, v1 = acc[ai][0][m][1] * sc, v2 = acc[ai][1][m][0] * sc, v3 = acc[ai][1][m][1] * sc;
                u32x4 w; w.x = pk_fp8x4(v0[0], v0[1], v0[2], v0[3]); w.y = pk_fp8x4(v1[0], v1[1], v1[2], v1[3]);
                w.z = pk_fp8x4(v2[0], v2[1], v2[2], v2[3]); w.w = pk_fp8x4(v3[0], v3[1], v3[2], v3[3]);
                *(u32x4*)((unsigned char*)Y + row * DM + 256 * u.pn + 64 * wc + 16 * fq) = w;
            }
    }
};

typedef EpiDN_<false> EpiDN; typedef EpiDN_<true> EpiDN8;

struct Args { const float* in[26]; float* out; unsigned char* ws; int ph_lo, ph_hi; };
struct Frame { LAS unsigned char* lds; unsigned char* ws; unsigned* ctl; int tid, lane, wave, G, bid; };
typedef __attribute__((address_space(4))) const unsigned char* kaptr_t;
__device__ __forceinline__ const float* inp(int i) { kaptr_t ka = (kaptr_t)__builtin_amdgcn_kernarg_segment_ptr(); asm volatile("" : "+s"(ka));
    const unsigned long long v = *(__attribute__((address_space(4))) const unsigned long long*)(ka + 8 * i); return (const float*)(GAS const float*)v; }
__device__ __forceinline__ float* outp_ptr() { kaptr_t ka = (kaptr_t)__builtin_amdgcn_kernarg_segment_ptr(); asm volatile("" : "+s"(ka));
    const unsigned long long v = *(__attribute__((address_space(4))) const unsigned long long*)(ka + 8 * 26); return (float*)(GAS float*)v; }

__device__ __forceinline__ int srccol_id(int R) { return R; }
struct CvtDesc { const float* W; bf16_t* WT; int K, N, NR, kind; };
__device__ __forceinline__ int cvt_col(int kind, int R);
__device__ __forceinline__ void cvt_load(const CvtDesc& d, int it, int lane, f32x4 (&v)[8]) {
    const int nblk = d.NR / 32, kb = it / nblk, nb = it % nblk, k0 = 64 * kb, r0 = 32 * nb, kk8 = lane >> 3, gp = lane & 7;
    const int sc = cvt_col(d.kind, r0 + 4 * gp);
#pragma unroll
    for (int i = 0; i < 8; ++i) v[i] = sc >= 0 ? *(const f32x4*)(d.W + (size_t)(k0 + 8 * i + kk8) * d.N + sc) : (f32x4){0.f, 0.f, 0.f, 0.f};
}
__device__ __forceinline__ void cvt_store(const CvtDesc& d, int it, int lane, const f32x4 (&v)[8], LAS float* scr) {
    const int nblk = d.NR / 32, kb = it / nblk, nb = it % nblk, k0 = 64 * kb, r0 = 32 * nb, kk8 = lane >> 3, gp = lane & 7;
#pragma unroll
    for (int i = 0; i < 8; ++i) { LAS float* p = scr + (8 * i + kk8) * 33 + 4 * gp; p[0] = v[i][0]; p[1] = v[i][1]; p[2] = v[i][2]; p[3] = v[i][3]; }
    LDS_WAIT(); asm volatile("" ::: "memory");
    const int c = lane & 7;
    if (d.kind == 5 || d.kind == 6) {
        const int c4 = lane & 3;
#pragma unroll
        for (int j = 0; j < 2; ++j) { const int n = (lane >> 2) + 16 * j; const LAS float* s = scr + (16 * c4) * 33 + n;
            u32x4 o; o.x = pk_fp8x4(s[0 * 33] * F8_WSCALE, s[1 * 33] * F8_WSCALE, s[2 * 33] * F8_WSCALE, s[3 * 33] * F8_WSCALE); o.y = pk_fp8x4(s[4 * 33] * F8_WSCALE, s[5 * 33] * F8_WSCALE, s[6 * 33] * F8_WSCALE, s[7 * 33] * F8_WSCALE);
            o.z = pk_fp8x4(s[8 * 33] * F8_WSCALE, s[9 * 33] * F8_WSCALE, s[10 * 33] * F8_WSCALE, s[11 * 33] * F8_WSCALE); o.w = pk_fp8x4(s[12 * 33] * F8_WSCALE, s[13 * 33] * F8_WSCALE, s[14 * 33] * F8_WSCALE, s[15 * 33] * F8_WSCALE);
            *(u32x4*)((unsigned char*)d.WT + (size_t)(r0 + n) * d.K + k0 + 16 * c4) = o; }
    } else {
#pragma unroll
    for (int j = 0; j < 4; ++j) { const int n = (lane >> 3) + 8 * j; const LAS float* s = scr + (8 * c) * 33 + n;
        u32x4 o; o.x = cvt_pk_bf16(s[0 * 33], s[1 * 33]); o.y = cvt_pk_bf16(s[2 * 33], s[3 * 33]); o.z = cvt_pk_bf16(s[4 * 33], s[5 * 33]); o.w = cvt_pk_bf16(s[6 * 33], s[7 * 33]);
        if (d.kind == 8) {
            const int k8 = (k0 >> 3) + c, rn = r0 + n; *(u32x4*)(d.WT + ((((size_t)(rn >> 5) * 256 + (k8 >> 1)) * 64 + (k8 & 1) * 32 + (rn & 31)) << 3)) = o; }
        else *(u32x4*)(d.WT + (size_t)(r0 + n) * d.K + k0 + 8 * c) = o; }
    }
    LDS_WAIT(); asm volatile("" ::: "memory");
}
struct ColIn0 { __device__ __forceinline__ int operator()(int R) const { const int ht = R >> 7; return 128 * ht + map_col(ht_map(ht_type(0, ht)), R & 127); } };
struct ColIn1 { __device__ __forceinline__ int operator()(int R) const { const int ht = R >> 7; const int c = 128 * ht + map_col(ht_map(ht_type(1, ht)), R & 127); return c < N1R ? c : -1; } };
struct ColId  { __device__ __forceinline__ int operator()(int R) const { return R; } };
struct ColGU  { __device__ __forceinline__ int operator()(int R) const { return 512 * ((R >> 7) & 1) + 128 * (R >> 8) + map_col(MAP_PLAIN, R & 127); } };
struct ColDN  { __device__ __forceinline__ int operator()(int R) const { return (R & ~127) + map_col(MAP_PLAIN, R & 127); } };
struct ColDN2 { __device__ __forceinline__ int operator()(int R) const { const int inner = map_col(MAP_PLAIN, R & 127), bj = (R >> 7) & 1; return (R & ~255) + 64 * (inner >> 5) + 16 * ((inner >> 3) & 3) + 8 * bj + (inner & 7); } };

namespace cvi {
constexpr int I_AIN = 32 * (N0 / 32), I_SQ = 32 * (DM / 32), I_CIN = 32 * (N1 / 32), I_W1 = 64 * 4, I_W2 = 2 * 4, I_RT = 32 * 2, I_GU = 32 * 32, I_DN = 8 * 64;
constexpr int O1 = I_AIN, O2 = O1 + I_SQ, O3 = O2 + I_CIN, O4 = O3 + I_SQ, O5 = O4 + 2 * I_W1, O6 = O5 + 2 * I_W2, O7 = O6 + 2 * I_RT, O8 = O7 + 130 * I_GU, O9 = O8 + 130 * I_DN;
}
__device__ __forceinline__ void cvt_pipeline(const Frame& F, const Args& A, int cb, int cG, int mb_lo, int mb_hi, int sm_lo, int sm_hi, int sm_w0, int sm_st) {
    using namespace cvi;
    unsigned char* ws = F.ws; const int ln = fresh_lane();
    LAS float* scr = (LAS float*)(F.lds + F.wave * 16384);
    auto desc_of = [&](int it, int& li) -> CvtDesc {
        CvtDesc d;
        if (it >= O7) {
            if (it < O8) { const int r = it - O7, mi = r / I_GU, layer = mi / 65, e = mi % 65; li = r % I_GU;
                d.W = e < NEXP ? inp(22) + ((size_t)layer * NEXP + e) * DM * 1024 : inp(24) + (size_t)layer * DM * 1024;
                d.WT = (bf16_t*)(ws + WS_WGU + (size_t)layer * 65 * WGU_E + (size_t)e * (WGU_E / 2)); d.K = DM; d.N = 1024; d.NR = 1024; d.kind = 5; }
            else { const int r = it - O8, mi = r / I_DN, layer = mi / 65, e = mi % 65; li = r % I_DN;
                d.W = e < NEXP ? inp(23) + ((size_t)layer * NEXP + e) * EDIM * DM : inp(25) + (size_t)layer * EDIM * DM;
                d.WT = (bf16_t*)(ws + WS_WDN + (size_t)mi * WDN_E); d.K = EDIM; d.N = DM; d.NR = DM; d.kind = 7; }
        }
        else if (it < O1) { li = it; d.W = inp(1); d.WT = (bf16_t*)(ws + WS_WAIN); d.K = DM; d.N = N0; d.NR = N0; d.kind = 1; }
        else if (it < O2) { li = it - O1; d.W = inp(7); d.WT = (bf16_t*)(ws + WS_WAOUT); d.K = DM; d.N = DM; d.NR = DM; d.kind = 4; }
        else if (it < O3) { li = it - O2; d.W = inp(8); d.WT = (bf16_t*)(ws + WS_WCIN); d.K = DM; d.N = N1R; d.NR = N1; d.kind = 2; }
        else if (it < O4) { li = it - O3; d.W = inp(15); d.WT = (bf16_t*)(ws + WS_WCOUT); d.K = DM; d.N = DM; d.NR = DM; d.kind = 4; }
        else if (it < O5) { const int r = it - O4, kv = r / I_W1; li = r % I_W1; d.W = inp(kv ? 13 : 10); d.WT = (bf16_t*)(ws + (kv ? WS_W1VT : WS_W1KT)); d.K = 4096; d.N = 128; d.NR = 128; d.kind = 8; }
        else if (it < O6) { const int r = it - O5, kv = r / I_W2; li = r % I_W2; d.W = inp(kv ? 14 : 11); d.WT = (bf16_t*)(ws + (kv ? WS_W2VT : WS_W2KT)); d.K = 128; d.N = 128; d.NR = 128; d.kind = 0; }
        else { const int r = it - O6, layer = r / I_RT; li = r % I_RT; d.W = inp(20) + (size_t)layer * DM * 64; d.WT = (bf16_t*)(ws + WS_WRT + (size_t)layer * 64 * DM * 2); d.K = DM; d.N = 64; d.NR = 64; d.kind = 0; }
        return d;
    };
    constexpr int NMB_GU = 130 * 32;
    const int nq_exp = (cb >= 0 && mb_lo + cb < mb_hi) ? 4 * ((mb_hi - 1 - mb_lo - cb) / cG + 1) : 0;
    auto item_of = [&](int q) -> int {
        if (q < nq_exp) { const int mb = mb_lo + cb + cG * (q >> 2), kbl = q & 3, nbl = F.wave;
            if (mb < NMB_GU) { const int mi = mb >> 5, r = mb & 31; return O7 + mi * I_GU + (4 * (r >> 2) + kbl) * 32 + 8 * (r & 3) + nbl; }
            const int m2 = mb - NMB_GU, mi = m2 >> 4, r = m2 & 15; return O8 + mi * I_DN + (4 * (r >> 3) + kbl) * 64 + 8 * (r & 7) + nbl; }
        const int it = sm_lo + sm_w0 + sm_st * (q - nq_exp); return it < sm_hi ? it : -1;
    };
    { int q = 0; int id0 = item_of(0);
      if (id0 >= 0) {
        int l0, l1 = 0, l2 = 0; CvtDesc d0 = desc_of(id0, l0), d1 = d0, d2 = d0; f32x4 v0[8], v1[8], v2[8];
        cvt_load(d0, l0, ln, v0);
        int id1 = item_of(1); if (id1 >= 0) { d1 = desc_of(id1, l1); cvt_load(d1, l1, ln, v1); }
        for (;;) {
            const int id2 = id1 >= 0 ? item_of(q + 2) : -1;
            if (id2 >= 0) { d2 = desc_of(id2, l2); cvt_load(d2, l2, ln, v2); }
            cvt_store(d0, l0, ln, v0, scr);
            if (id1 < 0) break;
            d0 = d1; l0 = l1; d1 = d2; l1 = l2; id1 = id2; ++q;
#pragma unroll
            for (int i = 0; i < 8; ++i) { v0[i] = v1[i]; v1[i] = v2[i]; }
        }
      } }
}
constexpr int NCONV = 64, NMB_ALL = 130 * 32 + 130 * 16, CVT_CH = 1;
__device__ __forceinline__ void cvt_dynamic(const Frame& F, const Args& A, int phase_idx, int nworkers, bool is_worker, bool drain) {
    unsigned* qn = F.ctl + CW_QNEXT; unsigned* done = F.ctl + CW_DONE + 64 * phase_idx;
    LAS int* slot = (LAS int*)(F.lds + MISC_OFF + MO_GEN); const int tid = F.wave * 64 + fresh_lane();
    __syncthreads();
    if (is_worker && !drain && tid == 0) __hip_atomic_fetch_add(done, 1u, __ATOMIC_RELAXED, __HIP_MEMORY_SCOPE_AGENT);
    constexpr int NSM = (cvi::O6 - cvi::O2 + 63) / 64, NCH = NSM + (NMB_ALL + CVT_CH - 1) / CVT_CH;
    for (;;) {
        if (tid == 0) { int c = -1;
            const bool go = drain || __hip_atomic_load(done, __ATOMIC_RELAXED, __HIP_MEMORY_SCOPE_AGENT) < (unsigned)nworkers;
            if (go) { c = (int)__hip_atomic_fetch_add(qn, 1u, __ATOMIC_RELAXED, __HIP_MEMORY_SCOPE_AGENT); if (c >= NCH) c = -1; }
            *slot = c; }
        __syncthreads();
        const int c = __builtin_amdgcn_readfirstlane(*slot);
        __syncthreads();
        if (c < 0) break;
        if (c < NSM) { const int lo = cvi::O2 + 64 * c, hi = lo + 64 < cvi::O6 ? lo + 64 : cvi::O6; cvt_pipeline(F, A, -1, 1, 0, 0, lo, hi, F.wave, 8); }
        else { const int lo = (c - NSM) * CVT_CH, hi = lo + CVT_CH < NMB_ALL ? lo + CVT_CH : NMB_ALL; cvt_pipeline(F, A, 0, 1, lo, hi, 0, 0, 0, 1); }
    }
}
__device__ __forceinline__ void p0_prologue(const Frame& F, const Args& A) {
    unsigned char* ws = F.ws;
    cvt_pipeline(F, A, -1, 1, 0, 0, 0, cvi::O1, F.bid * 8 + F.wave, F.G * 8);
    { const float* x = inp(0); bf16_t* xb = (bf16_t*)(ws + WS_XB);
      const size_t NP = (size_t)T * DM / 8, st = (size_t)F.G * 512;
      size_t i = (size_t)F.bid * 512 + F.tid;
      for (; i + 3 * st < NP; i += 4 * st) {
          f32x4 a[4], b[4];
#pragma unroll
          for (int u = 0; u < 4; ++u) { a[u] = *(const f32x4*)(x + (i + u * st) * 8); b[u] = *(const f32x4*)(x + (i + u * st) * 8 + 4); }
#pragma unroll
          for (int u = 0; u < 4; ++u) { u32x4 w; w.x = cvt_pk_bf16(a[u][0], a[u][1]); w.y = cvt_pk_bf16(a[u][2], a[u][3]); w.z = cvt_pk_bf16(b[u][0], b[u][1]); w.w = cvt_pk_bf16(b[u][2], b[u][3]);
              *(u32x4*)(xb + (i + u * st) * 8) = w; } }
      for (; i < NP; i += st) {
          const f32x4 a = *(const f32x4*)(x + i * 8), b = *(const f32x4*)(x + i * 8 + 4);
          u32x4 w; w.x = cvt_pk_bf16(a[0], a[1]); w.y = cvt_pk_bf16(a[2], a[3]); w.z = cvt_pk_bf16(b[0], b[1]); w.w = cvt_pk_bf16(b[2], b[3]);
          *(u32x4*)(xb + i * 8) = w; } }
    { f32x2* r128 = (f32x2*)(ws + WS_ROPE128); f32x2* r64 = (f32x2*)(ws + WS_ROPE64);
      for (int i = F.bid * 512 + F.tid; i < SEQ * 96; i += F.G * 512) {
          int pos, idx; float inv; f32x2* dst;
          if (i < SEQ * 64) { pos = i >> 6; idx = i & 63; inv = powf(10000.0f, -(float)idx * 2.0f / 128.0f); dst = r128 + i; }
          else { const int j = i - SEQ * 64; pos = j >> 5; idx = j & 31; inv = powf(10000.0f, -(float)idx * 2.0f / 64.0f); dst = r64 + j; }
          const float ang = (float)pos * inv;
          const double rev = (double)ang * 0.15915494309189533577; const double fr = rev - __builtin_rint(rev); const float f = (float)fr;
          f32x2 cs; cs.x = __builtin_amdgcn_cosf(f); cs.y = __builtin_amdgcn_sinf(f); *dst = cs; } }
}
__device__ __forceinline__ void pe_bias(const Frame& F, const Args& A) {
    unsigned char* ws = F.ws; const int tid = F.wave * 64 + fresh_lane();
    if (F.bid >= F.G - 2) {
        const int kv = F.G - 1 - F.bid; const float* pe = inp(kv ? 12 : 9); const float* w1 = inp(kv ? 13 : 10);
        const int jq = tid & 31, part = tid >> 5; f32x4 s = {0.f, 0.f, 0.f, 0.f};
#pragma unroll 16
        for (int k = part * 256; k < part * 256 + 256; ++k) s += *(const f32x4*)(w1 + (size_t)k * 128 + 4 * jq) * pe[k];
        LAS f32x4* red = (LAS f32x4*)(F.lds + MISC_OFF + MO_GEN);
        __syncthreads();
        red[tid] = s; __syncthreads();
        if (tid < 32) { f32x4 t = red[tid];
#pragma unroll
            for (int pp = 1; pp < 16; ++pp) t += red[tid + 32 * pp];
            *(f32x4*)((float*)(ws + WS_PEB) + kv * 128 + 4 * tid) = t; }
        __syncthreads();
    }
}

__device__ __forceinline__ int cvt_col(int kind, int R) {
    if (kind == 1) return ColIn0()(R);
    if (kind == 2) return ColIn1()(R);
    if (kind == 3 || kind == 5) return ColGU()(R);
    if (kind == 4 || kind == 6) return ColDN()(R);
    if (kind == 7) return ColDN2()(R);
    return R;
}

struct RowLN { f32x4 v[8]; float mean, rstd; };
__device__ __forceinline__ void ln_load_stats(RowLN& r, const float* y, int lane) {
    float s = 0.f;
#pragma unroll
    for (int j = 0; j < 4; ++j) { const float* p = y + 8 * (64 * j + lane); r.v[2 * j] = *(const f32x4*)p; r.v[2 * j + 1] = *(const f32x4*)(p + 4);
        s += (r.v[2 * j][0] + r.v[2 * j][1]) + (r.v[2 * j][2] + r.v[2 * j][3]) + (r.v[2 * j + 1][0] + r.v[2 * j + 1][1]) + (r.v[2 * j + 1][2] + r.v[2 * j + 1][3]); }
    r.mean = wave_sum(s) * (1.0f / DM); float q = 0.f;
#pragma unroll
    for (int i = 0; i < 8; ++i) { const f32x4 d = r.v[i] - r.mean; q += (d[0] * d[0] + d[1] * d[1]) + (d[2] * d[2] + d[3] * d[3]); }
    r.rstd = 1.0f / sqrtf(wave_sum(q) * (1.0f / DM) + LN_EPS);
}
__device__ __forceinline__ void row_load_bf16(RowLN& r, const bf16_t* y, int lane) {
#pragma unroll
    for (int j = 0; j < 4; ++j) { const u32x4 q = *(const u32x4*)(y + 8 * (64 * j + lane));
        r.v[2 * j] = (f32x4){bflo(q.x), bfhi(q.x), bflo(q.y), bfhi(q.y)}; r.v[2 * j + 1] = (f32x4){bflo(q.z), bfhi(q.z), bflo(q.w), bfhi(q.w)}; }
}
__device__ __forceinline__ void ln_stats_only(RowLN& r) {
    float s = 0.f;
#pragma unroll
    for (int i = 0; i < 8; ++i) s += (r.v[i][0] + r.v[i][1]) + (r.v[i][2] + r.v[i][3]);
    r.mean = wave_sum(s) * (1.0f / DM); float q = 0.f;
#pragma unroll
    for (int i = 0; i < 8; ++i) { const f32x4 d = r.v[i] - r.mean; q += (d[0] * d[0] + d[1] * d[1]) + (d[2] * d[2] + d[3] * d[3]); }
    r.rstd = 1.0f / sqrtf(wave_sum(q) * (1.0f / DM) + LN_EPS);
}
__device__ __forceinline__ void ln_apply(RowLN& r, const float* g, const float* b, int lane) {
#pragma unroll
    for (int j = 0; j < 4; ++j) { const int c = 8 * (64 * j + lane);
        const f32x4 g0 = *(const f32x4*)(g + c), g1 = *(const f32x4*)(g + c + 4), b0 = *(const f32x4*)(b + c), b1 = *(const f32x4*)(b + c + 4);
        r.v[2 * j] = (r.v[2 * j] - r.mean) * r.rstd * g0 + b0; r.v[2 * j + 1] = (r.v[2 * j + 1] - r.mean) * r.rstd * g1 + b1; }
}
__device__ __forceinline__ void ln_apply_lds(RowLN& r, const LAS float* g, const LAS float* b, int lane) {
#pragma unroll
    for (int j = 0; j < 4; ++j) { const int c = 8 * (64 * j + lane);
        const f32x4 g0 = *(const LAS f32x4*)(g + c), g1 = *(const LAS f32x4*)(g + c + 4), b0 = *(const LAS f32x4*)(b + c), b1 = *(const LAS f32x4*)(b + c + 4);
        r.v[2 * j] = (r.v[2 * j] - r.mean) * r.rstd * g0 + b0; r.v[2 * j + 1] = (r.v[2 * j + 1] - r.mean) * r.rstd * g1 + b1; }
}
__device__ __forceinline__ void row_store_bf16(const RowLN& r, bf16_t* o, int lane) {
#pragma unroll
    for (int j = 0; j < 4; ++j) { u32x4 w; w.x = cvt_pk_bf16(r.v[2 * j][0], r.v[2 * j][1]); w.y = cvt_pk_bf16(r.v[2 * j][2], r.v[2 * j][3]); w.z = cvt_pk_bf16(r.v[2 * j + 1][0], r.v[2 * j + 1][1]); w.w = cvt_pk_bf16(r.v[2 * j + 1][2], r.v[2 * j + 1][3]);
        *(u32x4*)(o + 8 * (64 * j + lane)) = w; }
}

__device__ __forceinline__ void phase_ln_router(const Frame& F, const Args& A, int layer) {
    unsigned char* ws = F.ws;
    const bf16_t* y1 = (const bf16_t*)(ws + WS_Y1); bf16_t* hb = (bf16_t*)(ws + WS_HB); float* stats = (float*)(ws + WS_STATS);
    const float* g = inp(16) + (size_t)layer * DM; const float* b = inp(17) + (size_t)layer * DM;
    const bf16_t* wrt = (const bf16_t*)(ws + WS_WRT + (size_t)layer * 64 * DM * 2);
    const float* rbias = inp(21) + (size_t)layer * NEXP;
    unsigned* gcnt = F.ctl + CW_CNT + layer * 64 * 64;
    int* toke = (int*)(ws + WS_TOKE); int* tokp = (int*)(ws + WS_TOKP); float* tokw = (float*)(ws + WS_TOKW); int* list = (int*)(ws + WS_LIST);
    LAS float* lg = (LAS float*)F.lds; LAS float* bs = lg + 64 * 65;
    LAS int* sel_e = (LAS int*)(bs + 64 * 65); LAS int* sel_lp = sel_e + 512; LAS float* sel_w = (LAS float*)(sel_lp + 512);
    LAS int* lcnt = (LAS int*)(sel_w + 512); LAS int* gbase = lcnt + 64;
    LAS float* pl = (LAS float*)(F.lds + 65536);
    __syncthreads();
    { const f32x4 a = *(const f32x4*)(g + 4 * F.tid), c = *(const f32x4*)(b + 4 * F.tid); *(LAS f32x4*)(pl + 4 * F.tid) = a; *(LAS f32x4*)(pl + 2048 + 4 * F.tid) = c; }
    __syncthreads();
    for (int blk = F.bid; blk < T / 64; blk += F.G) {
        const int row0 = blk * 64;
        if (F.tid < 64) lcnt[F.tid] = 0;
        { RowLN rn;
          row_load_bf16(rn, y1 + (size_t)(row0 + F.wave * 8) * DM, F.lane);
          for (int i = 0; i < 8; ++i) { const int row = row0 + F.wave * 8 + i; RowLN r = rn;
            if (i < 7) row_load_bf16(rn, y1 + (size_t)(row + 1) * DM, F.lane);
            ln_stats_only(r);
            if (F.lane == 0) { stats[2 * row] = r.mean; stats[2 * row + 1] = r.rstd; }
            ln_apply_lds(r, pl, pl + 2048, F.lane); row_store_bf16(r, hb + (size_t)row * DM, F.lane);
            { unsigned char* h8 = ws + WS_HB8 + (size_t)row * DM;
#pragma unroll
                for (int j = 0; j < 4; ++j) { u32x2 w; w.x = pk_fp8x4(r.v[2 * j][0], r.v[2 * j][1], r.v[2 * j][2], r.v[2 * j][3]); w.y = pk_fp8x4(r.v[2 * j + 1][0], r.v[2 * j + 1][1], r.v[2 * j + 1][2], r.v[2 * j + 1][3]); *(u32x2*)(h8 + 8 * (64 * j + F.lane)) = w; } } } }
        wg_self_visible(F.wave);
        { const int kh = F.wave & 1, tb2 = F.wave >> 1, rb2 = tb2 >> 1, eb = tb2 & 1, fr = F.lane & 15, kq = F.lane >> 4;
          const bf16_t* ap0 = hb + (size_t)(row0 + 32 * rb2 + fr) * DM + 8 * kq + 1024 * kh; const bf16_t* ap1 = ap0 + (size_t)16 * DM;
          const bf16_t* bp0 = wrt + (size_t)(32 * eb + fr) * DM + 8 * kq + 1024 * kh; const bf16_t* bp1 = bp0 + (size_t)16 * DM;
          f32x4 c00 = {0.f, 0.f, 0.f, 0.f}, c01 = c00, c10 = c00, c11 = c00;
#pragma unroll 8
          for (int ks = 0; ks < DM / 64; ++ks) { const bf16x8 a0 = *(const bf16x8*)(ap0 + 32 * ks), a1 = *(const bf16x8*)(ap1 + 32 * ks), b0 = *(const bf16x8*)(bp0 + 32 * ks), b1 = *(const bf16x8*)(bp1 + 32 * ks);
              c00 = __builtin_amdgcn_mfma_f32_16x16x32_bf16(a0, b0, c00, 0, 0, 0); c01 = __builtin_amdgcn_mfma_f32_16x16x32_bf16(a0, b1, c01, 0, 0, 0);
              c10 = __builtin_amdgcn_mfma_f32_16x16x32_bf16(a1, b0, c10, 0, 0, 0); c11 = __builtin_amdgcn_mfma_f32_16x16x32_bf16(a1, b1, c11, 0, 0, 0); }
          LAS float* lo_ = kh ? bs : lg;
#pragma unroll
          for (int rg = 0; rg < 4; ++rg) { const int r = 32 * rb2 + 4 * kq + rg;
              lo_[r * 65 + 32 * eb + fr] = c00[rg]; lo_[r * 65 + 32 * eb + 16 + fr] = c01[rg]; lo_[(r + 16) * 65 + 32 * eb + fr] = c10[rg]; lo_[(r + 16) * 65 + 32 * eb + 16 + fr] = c11[rg]; } }
        __syncthreads();
        { const int e = F.lane, grp = e >> 3; const float rb = rbias[e];
          for (int i = 0; i < 8; ++i) { const int r = 8 * F.wave + i;
            const float sc = 1.0f / (1.0f + __expf(-(lg[r * 65 + e] + bs[r * 65 + e]))), v = sc + rb;
            float m1 = v; m1 = fmaxf(m1, swz_xor<1>(m1)); m1 = fmaxf(m1, swz_xor<2>(m1)); m1 = fmaxf(m1, swz_xor<4>(m1));
            const unsigned long long eq = __ballot(v == m1) >> (8 * grp); const int first = __builtin_ctzll(eq | 0x100ull);
            float v2 = ((e & 7) == first) ? -3e38f : v; v2 = fmaxf(v2, swz_xor<1>(v2)); v2 = fmaxf(v2, swz_xor<2>(v2)); v2 = fmaxf(v2, swz_xor<4>(v2));
            const float gs = m1 + v2;
            int grank = 0;
#pragma unroll
            for (int gq = 0; gq < 8; ++gq) { const float o = __int_as_float(__builtin_amdgcn_readlane(__float_as_int(gs), 8 * gq)); grank += (o > gs || (o == gs && gq < grp)) ? 1 : 0; }
            const float vc = grank < TOPKG ? v : NEGF;
            int rank = 0;
#pragma unroll
            for (int q = 0; q < 64; ++q) { const float o = __int_as_float(__builtin_amdgcn_readlane(__float_as_int(vc), q)); rank += (o > vc || (o == vc && q < e)) ? 1 : 0; }
            const bool pick = rank < TOPK;
            const float wsum = wave_sum(pick ? sc : 0.f);
            if (pick) { sel_e[r * 8 + rank] = e; sel_w[r * 8 + rank] = sc * (2.5f / wsum); sel_lp[r * 8 + rank] = __hip_atomic_fetch_add(&lcnt[e], 1, __ATOMIC_RELAXED, __HIP_MEMORY_SCOPE_WORKGROUP); } } }
        __syncthreads();
        if (F.tid < 64) { const int n = lcnt[F.tid]; gbase[F.tid] = n > 0 ? (int)atomicAdd(&gcnt[F.tid * 64], (unsigned)n) : 0; }
        __syncthreads();
        { const int r = F.tid >> 3, k = F.tid & 7, tok = row0 + r, e = sel_e[r * 8 + k], pos = gbase[e] + sel_lp[r * 8 + k];
          toke[tok * 8 + k] = e; tokp[tok * 8 + k] = pos; tokw[tok * 8 + k] = sel_w[r * 8 + k]; list[(size_t)e * T + pos] = tok; }
        __syncthreads();
    }
}

__device__ __forceinline__ MoeTabs build_moe_tabs(const Frame& F, int layer) {
    LAS int* tpre = (LAS int*)(F.lds + MISC_OFF + MO_TPRE); LAS int* cnt = (LAS int*)(F.lds + MISC_OFF + MO_CNT); LAS unsigned char* etab = (LAS unsigned char*)(F.lds + MISC_OFF + MO_ETAB);
    const unsigned* gcnt = F.ctl + CW_CNT + layer * 64 * 64;
    __syncthreads();
    if (F.tid < 64) cnt[F.tid] = (int)__hip_atomic_load(gcnt + F.tid * 64, __ATOMIC_RELAXED, __HIP_MEMORY_SCOPE_AGENT);
    if (F.tid == 64) cnt[64] = T;
    __syncthreads();
    if (F.tid <= NEXP + 1) { int s = 0; for (int e = 0; e < F.tid; ++e) s += (cnt[e] + 255) >> 8; tpre[F.tid] = s; }
    __syncthreads();
    if (F.tid < NEXP) { const int hi = tpre[F.tid + 1]; for (int t = tpre[F.tid]; t < hi; ++t) etab[t] = (unsigned char)F.tid; }
    else if (F.tid < NEXP + 64) { const int t = tpre[NEXP] + (F.tid - NEXP); if (t < tpre[NEXP + 1]) etab[t] = (unsigned char)NEXP; }
    __syncthreads();
    MoeTabs tb; tb.tpre = tpre; tb.cnt = cnt; tb.etab = etab; tb.ntiles = __builtin_amdgcn_readfirstlane(tpre[65]); return tb;
}

__device__ __forceinline__ void phase_combine_ln(const Frame& F, const Args& A, int layer, const MoeTabs& tb) {
    unsigned char* ws = F.ws;
    const bf16_t* y1 = (const bf16_t*)(ws + WS_Y1); const float* stats = (const float*)(ws + WS_STATS);
    const float* g1 = inp(16) + (size_t)layer * DM; const float* b1 = inp(17) + (size_t)layer * DM;
    const float* g2 = inp(18) + (size_t)layer * DM; const float* b2 = inp(19) + (size_t)layer * DM;
    const int* toke = (const int*)(ws + WS_TOKE); const int* tokp = (const int*)(ws + WS_TOKP); const float* tokw = (const float*)(ws + WS_TOKW);
    const unsigned char* Y = (const unsigned char*)(ws + WS_YBUF);
    float* outf = outp_ptr(); bf16_t* xb = (bf16_t*)(ws + WS_XB);
    const int gw = F.bid * 8 + F.wave, NGW = F.G * 8;
    const int shared0 = __builtin_amdgcn_readfirstlane(tb.tpre[NEXP]) * 256;
    LAS float* pl = (LAS float*)F.lds;
    __syncthreads();
    { const f32x4 a = *(const f32x4*)(g1 + 4 * F.tid), b = *(const f32x4*)(b1 + 4 * F.tid), c = *(const f32x4*)(g2 + 4 * F.tid), d = *(const f32x4*)(b2 + 4 * F.tid);
      *(LAS f32x4*)(pl + 4 * F.tid) = a; *(LAS f32x4*)(pl + 2048 + 4 * F.tid) = b; *(LAS f32x4*)(pl + 4096 + 4 * F.tid) = c; *(LAS f32x4*)(pl + 6144 + 4 * F.tid) = d; }
    __syncthreads();
    for (int row = gw; row < T; row += NGW) {
        RowLN r;
        row_load_bf16(r, y1 + (size_t)row * DM, F.lane);
        r.mean = stats[2 * row]; r.rstd = stats[2 * row + 1];
        ln_apply_lds(r, pl, pl + 2048, F.lane);
#pragma unroll
        for (int i = 0; i < 8; ++i) r.v[i] = r.v[i] * DN_ALPHA;
        size_t srow[TOPK + 1]; float sw[TOPK + 1];
#pragma unroll
        for (int k = 0; k < TOPK; ++k) { const int e = toke[row * 8 + k]; srow[k] = (size_t)tb.tpre[e] * 256 + tokp[row * 8 + k]; sw[k] = tokw[row * 8 + k]; }
        srow[TOPK] = (size_t)shared0 + row; sw[TOPK] = 1.0f;
        u32x2 yq[TOPK + 1][4];
#pragma unroll
        for (int k = 0; k <= TOPK; ++k)
#pragma unroll
            for (int j = 0; j < 4; ++j) yq[k][j] = *(const u32x2*)(Y + srow[k] * DM + 8 * (64 * j + F.lane));
#pragma unroll
        for (int k = 0; k <= TOPK; ++k) { const float w = sw[k] * (1.0f / F8_YSCALE);
#pragma unroll
            for (int j = 0; j < 4; ++j) { const u32x2 q = yq[k][j];
                const f32x2 a = __builtin_amdgcn_cvt_pk_f32_fp8((int)q.x, false), b = __builtin_amdgcn_cvt_pk_f32_fp8((int)q.x, true), c = __builtin_amdgcn_cvt_pk_f32_fp8((int)q.y, false), d = __builtin_amdgcn_cvt_pk_f32_fp8((int)q.y, true);
                r.v[2 * j][0] += w * a[0]; r.v[2 * j][1] += w * a[1]; r.v[2 * j][2] += w * b[0]; r.v[2 * j][3] += w * b[1];
                r.v[2 * j + 1][0] += w * c[0]; r.v[2 * j + 1][1] += w * c[1]; r.v[2 * j + 1][2] += w * d[0]; r.v[2 * j + 1][3] += w * d[1]; } }
        float s = 0.f;
#pragma unroll
        for (int i = 0; i < 8; ++i) s += (r.v[i][0] + r.v[i][1]) + (r.v[i][2] + r.v[i][3]);
        r.mean = wave_sum(s) * (1.0f / DM); float q = 0.f;
#pragma unroll
        for (int i = 0; i < 8; ++i) { const f32x4 d = r.v[i] - r.mean; q += (d[0] * d[0] + d[1] * d[1]) + (d[2] * d[2] + d[3] * d[3]); }
        r.rstd = 1.0f / sqrtf(wave_sum(q) * (1.0f / DM) + LN_EPS);
        ln_apply_lds(r, pl + 4096, pl + 6144, F.lane);
        if (layer == 0) row_store_bf16(r, xb + (size_t)row * DM, F.lane);
        else {
#pragma unroll
            for (int j = 0; j < 4; ++j) { float* p = outf + (size_t)row * DM + 8 * (64 * j + F.lane); *(f32x4*)p = r.v[2 * j]; *(f32x4*)(p + 4) = r.v[2 * j + 1]; } }
    }
}

__device__ __forceinline__ unsigned offb(unsigned row, unsigned ch) { return 256u * row + 16u * (ch ^ (((row & 3u) << 2) | ((row >> 2) & 3u))); }
__device__ __forceinline__ int crow(int r, int hi) { return (r & 3) + 8 * (r >> 2) + 4 * hi; }
#define MFMA32(a, b, c) __builtin_amdgcn_mfma_f32_32x32x16_bf16((a), (b), (c), 0, 0, 0)

struct KVRegs { u32x4 k0, k1, v0, v1; };
__device__ __forceinline__ void kv_gload(KVRegs& s, const bf16_t* K, const bf16_t* V, int ldk, int ldv, int key0, int tid) {
    const int r = tid >> 4, c = (tid & 15) * 8;
    s.k0 = *(const u32x4*)(K + (size_t)(key0 + r) * ldk + c); s.k1 = *(const u32x4*)(K + (size_t)(key0 + 32 + r) * ldk + c);
    s.v0 = *(const u32x4*)(V + (size_t)(key0 + r) * ldv + c); s.v1 = *(const u32x4*)(V + (size_t)(key0 + 32 + r) * ldv + c);
}
__device__ __forceinline__ void kv_lwrite(const KVRegs& s, LAS unsigned char* Kb, LAS unsigned char* Vb, int tid) {
    const unsigned o = offb(tid >> 4, tid & 15);
    *(LAS u32x4*)(Kb + o) = s.k0; *(LAS u32x4*)(Kb + o + 8192) = s.k1; *(LAS u32x4*)(Vb + o) = s.v0; *(LAS u32x4*)(Vb + o + 8192) = s.v1;
}
struct LaneGeo { int r, h, krow, kx; unsigned va0, va1, q; };
__device__ __forceinline__ LaneGeo lane_geo(int lane) {
    LaneGeo g; g.r = lane & 31; g.h = lane >> 5; g.krow = 256 * g.r; g.kx = ((g.r & 3) << 2) | ((g.r >> 2) & 3);
    const int blk = (lane >> 4) & 1, q = (lane & 15) >> 2, p = lane & 3;
    g.q = q;
    g.va0 = 256u * (4 * g.h + q) + 16u * ((2 * blk + (p >> 1)) ^ g.h) + 8u * (p & 1);
    g.va1 = 256u * (8 + 4 * g.h + q) + 16u * ((2 * blk + (p >> 1)) ^ (2 + g.h)) + 8u * (p & 1);
    return g;
}
template <int OFF> __device__ __forceinline__ s16x4 tr_read(unsigned a) { s16x4 r; asm volatile("ds_read_b64_tr_b16 %0, %1 offset:%2" : "=&v"(r) : "v"(a), "i"(OFF) : "memory"); return r; }
template <int N> __device__ __forceinline__ void lgk_wait() { asm volatile("s_waitcnt lgkmcnt(%0)" :: "i"(N) : "memory"); SBAR(); }
template <int N> __device__ __forceinline__ void lgk_wait_k(bf16x8& a) { asm volatile("s_waitcnt lgkmcnt(%1)" : "+v"(a) : "i"(N) : "memory"); SBAR(); }
template <int N> __device__ __forceinline__ void lgk_wait_v(s16x4& a, s16x4& b) { asm volatile("s_waitcnt lgkmcnt(%2)" : "+v"(a), "+v"(b) : "i"(N) : "memory"); SBAR(); }
#define PKV(L, H) (bf16x8){L[0], L[1], L[2], L[3], H[0], H[1], H[2], H[3]}
template <int I> __device__ __forceinline__ void v_issue(s16x4 (&vl)[16], s16x4 (&vh)[16], unsigned v0a, unsigned v1a, unsigned q) {
    constexpr int c = I >> 2, kk = I & 3; const unsigned o = 64u * ((unsigned)c ^ q);
    vl[I] = tr_read<4096 * kk>(v0a + o); vh[I] = tr_read<4096 * kk>(v1a + o);
}
template <int I> struct PVStep {
    static __device__ __forceinline__ void run(s16x4 (&vl)[16], s16x4 (&vh)[16], unsigned v0a, unsigned v1a, unsigned q, const bf16x8 (&pf)[4], f32x16 (&O)[4]) {
        constexpr int LEFT = 15 - I, W = LEFT < 7 ? 2 * LEFT : 14;
        lgk_wait_v<W>(vl[I], vh[I]);
        O[I >> 2] = MFMA32(PKV(vl[I], vh[I]), pf[I & 3], O[I >> 2]);
        SBAR();
        if constexpr (I + 8 < 16) { v_issue<I + 8>(vl, vh, v0a, v1a, q); }
        if constexpr (I + 1 < 16) PVStep<I + 1>::run(vl, vh, v0a, v1a, q, pf, O);
    }
};
template <int OFF> __device__ __forceinline__ bf16x8 k_read(unsigned a) { u32x4 r; asm volatile("ds_read_b128 %0, %1 offset:%2" : "=&v"(r) : "v"(a), "i"(OFF) : "memory"); return *reinterpret_cast<bf16x8*>(&r); }
#define KWAIT(n) do { asm volatile("s_waitcnt lgkmcnt(" #n ")" ::: "memory"); SBAR(); } while (0)
template <int I, int N> struct QKStep {
    template <int KS> static __device__ __forceinline__ void run(bf16x8 (&kf)[N], const unsigned (&ad)[KS], const bf16x8 (&qf)[KS], f32x16& S0, f32x16& S1) {
        constexpr int PRE = 8, LEFT = N - 1 - I, W = LEFT < PRE - 1 ? LEFT : PRE - 1;
        lgk_wait_k<W>(kf[I]);
        if constexpr ((I & 1) == 0) S0 = MFMA32(kf[I], qf[I >> 1], S0); else S1 = MFMA32(kf[I], qf[I >> 1], S1);
        SBAR();
        if constexpr (I + PRE < N) { kf[I + PRE] = k_read<((I + PRE) & 1) * 8192>(ad[(I + PRE) >> 1]); }
        if constexpr (I + 1 < N) QKStep<I + 1, N>::template run<KS>(kf, ad, qf, S0, S1);
    }
};
template <int KS, bool SCALE>
__device__ __forceinline__ void qk_tile(const LAS unsigned char* Kb, const bf16x8 (&qf)[KS], int kc0, const LaneGeo& g, float cs, f32x16& S0, f32x16& S1) {
    S0 = (f32x16){0.f, 0.f, 0.f, 0.f, 0.f, 0.f, 0.f, 0.f, 0.f, 0.f, 0.f, 0.f, 0.f, 0.f, 0.f, 0.f}; S1 = S0;
    unsigned kb = (unsigned)(uintptr_t)Kb + g.krow; asm volatile("" : "+v"(kb));
    unsigned ad[KS];
#pragma unroll
    for (int ks = 0; ks < KS; ++ks) ad[ks] = kb + (((2 * (kc0 + ks) + g.h) ^ g.kx) << 4);
    SBAR();
    bf16x8 kf[2 * KS];
    kf[0] = k_read<0>(ad[0]); kf[1] = k_read<8192>(ad[0]); kf[2] = k_read<0>(ad[1]); kf[3] = k_read<8192>(ad[1]);
    kf[4] = k_read<0>(ad[2]); kf[5] = k_read<8192>(ad[2]); kf[6] = k_read<0>(ad[3]); kf[7] = k_read<8192>(ad[3]);
    QKStep<0, 2 * KS>::template run<KS>(kf, ad, qf, S0, S1);
    SBAR();
    if constexpr (SCALE) {
#pragma unroll
        for (int i = 0; i < 16; ++i) { S0[i] *= cs; S1[i] *= cs; } }
}
struct SoftState { float m, l; };
#define ZERO16_ (f32x16){0.f, 0.f, 0.f, 0.f, 0.f, 0.f, 0.f, 0.f, 0.f, 0.f, 0.f, 0.f, 0.f, 0.f, 0.f, 0.f}
template <int KS, class MK>
__device__ __forceinline__ void attn_tile(const LAS unsigned char* Kb, unsigned Vaddr, const bf16x8 (&qf)[KS], int kc0, const LaneGeo& g, int kbase, int cls, const MK& mk, float cs,
                                          f32x16 (&O)[4], SoftState& st) {
    f32x16 S0, S1;
    qk_tile<KS, false>(Kb, qf, kc0, g, cs, S0, S1);
    s16x4 vl[16], vh[16];
    unsigned v0a = Vaddr + g.va0, v1a = Vaddr + g.va1; asm volatile("" : "+v"(v0a), "+v"(v1a));
    v_issue<0>(vl, vh, v0a, v1a, g.q); v_issue<1>(vl, vh, v0a, v1a, g.q); v_issue<2>(vl, vh, v0a, v1a, g.q); v_issue<3>(vl, vh, v0a, v1a, g.q);
    v_issue<4>(vl, vh, v0a, v1a, g.q); v_issue<5>(vl, vh, v0a, v1a, g.q); v_issue<6>(vl, vh, v0a, v1a, g.q); v_issue<7>(vl, vh, v0a, v1a, g.q);
    if (cls == 2) {
        asm volatile("" ::: "memory");
#pragma unroll
        for (int i = 0; i < 16; ++i) { const int key = kbase + crow(i, g.h); S0[i] = mk.valid(key) ? S0[i] : NEGS; S1[i] = mk.valid(key + 32) ? S1[i] : NEGS; }
    }
    float mx = fmaxf(S0[0], S1[0]);
#pragma unroll
    for (int i = 1; i < 16; ++i) mx = fmaxf(mx, fmaxf(S0[i], S1[i]));
    const bool dead = (cls == 3) && !mk.lane_on();
    mx = dead ? NEGS : mx;
    mx = max32(mx);
    const float mn = fmaxf(st.m, mx), alpha = fast_exp2((st.m - mn) * cs), mc = dead ? -1e30f : -mn * cs; st.m = mn;
    float ps = 0.f;
#pragma unroll
    for (int i = 0; i < 16; ++i) { S0[i] = fast_exp2(fmaf(S0[i], cs, mc)); S1[i] = fast_exp2(fmaf(S1[i], cs, mc)); ps += S0[i] + S1[i]; }
    st.l = st.l * alpha + ps;
    if (!__all(alpha == 1.0f)) {
        asm volatile("" ::: "memory");
#pragma unroll
        for (int c = 0; c < 4; ++c)
#pragma unroll
            for (int i = 0; i < 16; ++i) O[c][i] *= alpha;
    }
    bf16x8 pf[4];
    { u32x4 w;
      w.x = cvt_pk_bf16(S0[0], S0[1]); w.y = cvt_pk_bf16(S0[2], S0[3]); w.z = cvt_pk_bf16(S0[4], S0[5]); w.w = cvt_pk_bf16(S0[6], S0[7]); pf[0] = *reinterpret_cast<bf16x8*>(&w);
      w.x = cvt_pk_bf16(S0[8], S0[9]); w.y = cvt_pk_bf16(S0[10], S0[11]); w.z = cvt_pk_bf16(S0[12], S0[13]); w.w = cvt_pk_bf16(S0[14], S0[15]); pf[1] = *reinterpret_cast<bf16x8*>(&w);
      w.x = cvt_pk_bf16(S1[0], S1[1]); w.y = cvt_pk_bf16(S1[2], S1[3]); w.z = cvt_pk_bf16(S1[4], S1[5]); w.w = cvt_pk_bf16(S1[6], S1[7]); pf[2] = *reinterpret_cast<bf16x8*>(&w);
      w.x = cvt_pk_bf16(S1[8], S1[9]); w.y = cvt_pk_bf16(S1[10], S1[11]); w.z = cvt_pk_bf16(S1[12], S1[13]); w.w = cvt_pk_bf16(S1[14], S1[15]); pf[3] = *reinterpret_cast<bf16x8*>(&w); }
    SBAR();
    PVStep<0>::run(vl, vh, v0a, v1a, g.q, pf, O);
}
struct DmaOff { unsigned o[2]; };
__device__ __forceinline__ DmaOff dma_offsets(int ld, int wave, int lane) {
    DmaOff d;
#pragma unroll
    for (int i = 0; i < 2; ++i) { const int inst = wave + 8 * i, row = 4 * inst + (lane >> 4), chs = (lane & 15) ^ (((row & 3) << 2) | ((row >> 2) & 3)); d.o[i] = (unsigned)(row * ld + 8 * chs) * 2u; }
    return d;
}
__device__ __forceinline__ void tile_dma(LAS unsigned char* dst, const bf16_t* src, int ld, int key0, int wave, const DmaOff& d) {
    const char* base = (const char*)(src + (size_t)key0 * ld);
    unsigned z = 0u; asm volatile("" : "+v"(z));
#pragma unroll
    for (int i = 0; i < 2; ++i) __builtin_amdgcn_global_load_lds((const unsigned*)(base + (((unsigned long long)z << 32) | d.o[i])), (LAS unsigned*)(dst + (wave + 8 * i) * 1024), 16, 0, 0);
}
constexpr float SM_THR = 8.0f;
#define PIN(x) asm volatile("" : "+v"(x))
struct ParState { float mxa, mxb, alpha, mc; };
template <int I> __device__ __forceinline__ void fin_slice(f32x16& F0, f32x16& F1, float& ps, unsigned (&w0)[8], unsigned (&w1)[8]) {
    F0[I] = fast_exp2(F0[I]); F1[I] = fast_exp2(F1[I]); ps += F0[I] + F1[I];
    if constexpr ((I & 1) == 1) { w0[I >> 1] = cvt_pk_bf16(F0[I - 1], F0[I]); w1[I >> 1] = cvt_pk_bf16(F1[I - 1], F1[I]); PIN(w0[I >> 1]); PIN(w1[I >> 1]); }
    else { PIN(F0); PIN(F1); }
    PIN(ps);
}
template <int E> __device__ __forceinline__ void expo(f32x16& N0, f32x16& N1, float cs, float mc) { if constexpr (E < 16) N0[E] = fmaf(N0[E], cs, mc); else if constexpr (E < 32) N1[E - 16] = fmaf(N1[E - 16], cs, mc); }
template <int I> __device__ __forceinline__ void par_slice(f32x16& N0, f32x16& N1, ParState& ps, SoftState& st, bool dead, float cs) {
    if constexpr (I < 8) { ps.mxa = fmaxf(fmaxf(ps.mxa, N0[2 * I]), N0[2 * I + 1]); ps.mxb = fmaxf(fmaxf(ps.mxb, N1[2 * I]), N1[2 * I + 1]); }
    else if constexpr (I == 8) {
        float mx = fmaxf(ps.mxa, ps.mxb); mx = dead ? NEGS : mx; mx = max32(mx);
        const bool defer = __all((mx - st.m) * cs <= SM_THR);
        const float mn = defer ? st.m : fmaxf(st.m, mx);
        ps.alpha = defer ? 1.0f : fast_exp2((st.m - mn) * cs); ps.mc = dead ? -1e30f : -mn * cs; st.m = mn;
    } else { constexpr int E0 = 5 * (I - 9); expo<E0>(N0, N1, cs, ps.mc); expo<E0 + 1>(N0, N1, cs, ps.mc); expo<E0 + 2>(N0, N1, cs, ps.mc); expo<E0 + 3>(N0, N1, cs, ps.mc); expo<E0 + 4>(N0, N1, cs, ps.mc); }
    if constexpr (I < 8) { PIN(ps.mxa); PIN(ps.mxb); } else if constexpr (I == 8) { PIN(ps.alpha); PIN(ps.mc); PIN(st.m); } else { PIN(N0); PIN(N1); }
}
template <int I, int N, int KS, int PRE, int KOFF> struct QKF {
    static __device__ __forceinline__ void run(bf16x8 (&kf)[N], const unsigned (&ad)[KS], const bf16x8 (&qf)[KS], f32x16& N0, f32x16& N1, f32x16& F0, f32x16& F1, float& ps, unsigned (&w0)[8], unsigned (&w1)[8]) {
        constexpr int LEFT = N - 1 - I, W = LEFT < PRE - 1 ? LEFT : PRE - 1;
        lgk_wait_k<W>(kf[I]);
        if constexpr ((I & 1) == 0) N0 = MFMA32(kf[I], qf[I >> 1], N0); else N1 = MFMA32(kf[I], qf[I >> 1], N1);
        SBAR();
        if constexpr (I + PRE < N) { kf[I + PRE] = k_read<KOFF + ((I + PRE) & 1) * 8192>(ad[(I + PRE) >> 1]); }
        constexpr int SPS = 16 / N;
        fin_slice<I * SPS>(F0, F1, ps, w0, w1);
        if constexpr (SPS == 2) fin_slice<I * SPS + 1>(F0, F1, ps, w0, w1);
        if constexpr (I + 1 < N) QKF<I + 1, N, KS, PRE, KOFF>::run(kf, ad, qf, N0, N1, F0, F1, ps, w0, w1);
    }
};
template <int I, int VOFF> __device__ __forceinline__ void v_issue2(s16x4 (&vl)[16], s16x4 (&vh)[16], const unsigned (&va)[8]) {
    constexpr int c = I >> 2, kk = I & 3;
    vl[I] = tr_read<VOFF + 4096 * kk>(va[c]); vh[I] = tr_read<VOFF + 4096 * kk>(va[4 + c]);
}
template <int I, int VOFF> struct PVP {
    static __device__ __forceinline__ void run(s16x4 (&vl)[16], s16x4 (&vh)[16], const unsigned (&va)[8], const bf16x8 (&pf)[4], f32x16 (&O)[4],
                                               f32x16& N0, f32x16& N1, ParState& ps, SoftState& st, bool dead, float cs) {
        constexpr int LEFT = 15 - I, W = LEFT < 7 ? 2 * LEFT : 14;
        lgk_wait_v<W>(vl[I], vh[I]);
        O[I >> 2] = MFMA32(PKV(vl[I], vh[I]), pf[I & 3], O[I >> 2]);
        SBAR();
        if constexpr (I + 8 < 16) { v_issue2<I + 8, VOFF>(vl, vh, va); }
        par_slice<I>(N0, N1, ps, st, dead, cs);
        if constexpr (I + 1 < 16) PVP<I + 1, VOFF>::run(vl, vh, va, pf, O, N0, N1, ps, st, dead, cs);
    }
};
template <int I, int VOFF> struct PVOnly {
    static __device__ __forceinline__ void run(s16x4 (&vl)[16], s16x4 (&vh)[16], const unsigned (&va)[8], const bf16x8 (&pf)[4], f32x16 (&O)[4]) {
        constexpr int LEFT = 15 - I, W = LEFT < 7 ? 2 * LEFT : 14;
        lgk_wait_v<W>(vl[I], vh[I]);
        O[I >> 2] = MFMA32(PKV(vl[I], vh[I]), pf[I & 3], O[I >> 2]);
        SBAR();
        if constexpr (I + 8 < 16) { v_issue2<I + 8, VOFF>(vl, vh, va); }
        if constexpr (I + 1 < 16) PVOnly<I + 1, VOFF>::run(vl, vh, va, pf, O);
    }
};
template <int I> struct ParAlone { static __device__ __forceinline__ void run(f32x16& N0, f32x16& N1, ParState& ps, SoftState& st, bool dead, float cs) { par_slice<I>(N0, N1, ps, st, dead, cs); if constexpr (I + 1 < 16) ParAlone<I + 1>::run(N0, N1, ps, st, dead, cs); } };
template <int I> struct FinAlone { static __device__ __forceinline__ void run(f32x16& F0, f32x16& F1, float& ps, unsigned (&w0)[8], unsigned (&w1)[8]) { fin_slice<I>(F0, F1, ps, w0, w1); if constexpr (I + 1 < 16) FinAlone<I + 1>::run(F0, F1, ps, w0, w1); } };
template <class MK>
__device__ __forceinline__ bool tile_mask(f32x16& N0, f32x16& N1, const LaneGeo& g, int kbase, int cls, const MK& mk) {
    if (cls == 2) {
        asm volatile("" ::: "memory");
#pragma unroll
        for (int i = 0; i < 16; ++i) { const int key = kbase + crow(i, g.h); N0[i] = mk.valid(key) ? N0[i] : NEGS; N1[i] = mk.valid(key + 32) ? N1[i] : NEGS; }
    }
    return cls == 0 || (cls == 3 && !mk.lane_on());
}
__device__ __forceinline__ void pack_pf(const unsigned (&w0)[8], const unsigned (&w1)[8], bf16x8 (&pf)[4]) {
    u32x4 w;
    w.x = w0[0]; w.y = w0[1]; w.z = w0[2]; w.w = w0[3]; pf[0] = *reinterpret_cast<bf16x8*>(&w);
    w.x = w0[4]; w.y = w0[5]; w.z = w0[6]; w.w = w0[7]; pf[1] = *reinterpret_cast<bf16x8*>(&w);
    w.x = w1[0]; w.y = w1[1]; w.z = w1[2]; w.w = w1[3]; pf[2] = *reinterpret_cast<bf16x8*>(&w);
    w.x = w1[4]; w.y = w1[5]; w.z = w1[6]; w.w = w1[7]; pf[3] = *reinterpret_cast<bf16x8*>(&w);
}
__device__ __forceinline__ void o_rescale(f32x16 (&O)[4], float alpha) {
    if (!__all(alpha == 1.0f)) {
        asm volatile("" ::: "memory");
#pragma unroll
        for (int c = 0; c < 4; ++c)
#pragma unroll
            for (int i = 0; i < 16; ++i) O[c][i] *= alpha;
    }
}
template <int KS, class MK, int P>
__device__ __forceinline__ void stream_step(LAS unsigned char* lds, const bf16_t* K, const bf16_t* V, int ldk, int ldv, int kt0, int j, int nt, int wave, const DmaOff& dof,
                                            const bf16x8 (&qf)[KS], const unsigned (&ad)[KS], const unsigned (&va)[8], const LaneGeo& g, MK& mk, float cs, f32x16 (&O)[4], SoftState& st,
                                            f32x16& F0, f32x16& F1, f32x16& N0, f32x16& N1, float& alF) {
    asm volatile("s_waitcnt vmcnt(0)" ::: "memory");
    __syncthreads();
    if (j + 1 < nt) tile_dma(lds + (1 - P) * 16384, K, ldk, (kt0 + j + 1) * 64, wave, dof);
    tile_dma(lds + 32768 + P * 16384, V, ldv, (kt0 + j) * 64, wave, dof);
    const int kbase = (kt0 + j) * 64, cls = mk.prep(kbase);
    N0 = ZERO16_; N1 = ZERO16_;
    constexpr int KOFF = P * 16384, VOFF = 32768 + (1 - P) * 16384;
    SBAR();
    bf16x8 kf[2 * KS];
    kf[0] = k_read<KOFF>(ad[0]); kf[1] = k_read<KOFF + 8192>(ad[0]); kf[2] = k_read<KOFF>(ad[1]); kf[3] = k_read<KOFF + 8192>(ad[1]);
    if constexpr (MK::KPRE == 8) { kf[4] = k_read<KOFF>(ad[2]); kf[5] = k_read<KOFF + 8192>(ad[2]); kf[6] = k_read<KOFF>(ad[3]); kf[7] = k_read<KOFF + 8192>(ad[3]); }
    float ps = 0.f; unsigned w0[8], w1[8];
    QKF<0, 2 * KS, KS, MK::KPRE, KOFF>::run(kf, ad, qf, N0, N1, F0, F1, ps, w0, w1);
    SBAR();
    st.l = st.l * alF + ps; PIN(st.l);
    bf16x8 pf[4]; pack_pf(w0, w1, pf);
    const bool dead = tile_mask<MK>(N0, N1, g, kbase, cls, mk);
    s16x4 vl[16], vh[16];
    SBAR();
    v_issue2<0, VOFF>(vl, vh, va); v_issue2<1, VOFF>(vl, vh, va); v_issue2<2, VOFF>(vl, vh, va); v_issue2<3, VOFF>(vl, vh, va);
    v_issue2<4, VOFF>(vl, vh, va); v_issue2<5, VOFF>(vl, vh, va); v_issue2<6, VOFF>(vl, vh, va); v_issue2<7, VOFF>(vl, vh, va);
    ParState pr; pr.mxa = NEGS; pr.mxb = NEGS; pr.alpha = 1.0f; pr.mc = 0.f;
    PVP<0, VOFF>::run(vl, vh, va, pf, O, N0, N1, pr, st, dead, cs);
    SBAR();
    o_rescale(O, pr.alpha);
    alF = pr.alpha;
}
__device__ __forceinline__ void stream_tail(const unsigned (&va)[8], f32x16 (&O)[4], SoftState& st, f32x16& F0, f32x16& F1, float alF) {
    float ps = 0.f; unsigned w0[8], w1[8];
    FinAlone<0>::run(F0, F1, ps, w0, w1);
    st.l = st.l * alF + ps; PIN(st.l);
    bf16x8 pf[4]; pack_pf(w0, w1, pf);
    s16x4 vl[16], vh[16];
    constexpr int VOFF = 32768;
    SBAR();
    v_issue2<0, VOFF>(vl, vh, va); v_issue2<1, VOFF>(vl, vh, va); v_issue2<2, VOFF>(vl, vh, va); v_issue2<3, VOFF>(vl, vh, va);
    v_issue2<4, VOFF>(vl, vh, va); v_issue2<5, VOFF>(vl, vh, va); v_issue2<6, VOFF>(vl, vh, va); v_issue2<7, VOFF>(vl, vh, va);
    SBAR();
    PVOnly<0, VOFF>::run(vl, vh, va, pf, O);
}
template <int KS, class MK>
__device__ __forceinline__ void attn_stream(LAS unsigned char* lds, const bf16_t* K, const bf16_t* V, int ldk, int ldv, int kt0, int nt, int wave, int lane,
                                            const bf16x8 (&qf)[KS], int kc0, const LaneGeo& g, MK& mk, float cs, f32x16 (&O)[4], SoftState& st) {
    const DmaOff dof = dma_offsets(ldk, wave, lane);
    unsigned ad[KS], va[8];
    { const unsigned kb = (unsigned)(uintptr_t)lds + g.krow;
#pragma unroll
      for (int ks = 0; ks < KS; ++ks) { ad[ks] = kb + (((2 * (kc0 + ks) + g.h) ^ g.kx) << 4); PIN(ad[ks]); }
      const unsigned vb = (unsigned)(uintptr_t)lds;
#pragma unroll
      for (int c = 0; c < 4; ++c) { va[c] = vb + g.va0 + 64u * ((unsigned)c ^ g.q); va[4 + c] = vb + g.va1 + 64u * ((unsigned)c ^ g.q); PIN(va[c]); PIN(va[4 + c]); } }
    f32x16 A0, A1, B0, B1; float alF;
    __syncthreads();
    tile_dma(lds, K, ldk, kt0 * 64, wave, dof);
    asm volatile("s_waitcnt vmcnt(0)" ::: "memory");
    __syncthreads();
    if (nt > 1) tile_dma(lds + 16384, K, ldk, (kt0 + 1) * 64, wave, dof);
    tile_dma(lds + 32768, V, ldv, kt0 * 64, wave, dof);
    { const int kbase = kt0 * 64, cls = mk.prep(kbase);
      A0 = ZERO16_; A1 = ZERO16_;
      bf16x8 kf[2 * KS];
      kf[0] = k_read<0>(ad[0]); kf[1] = k_read<8192>(ad[0]); kf[2] = k_read<0>(ad[1]); kf[3] = k_read<8192>(ad[1]);
      kf[4] = k_read<0>(ad[2]); kf[5] = k_read<8192>(ad[2]); kf[6] = k_read<0>(ad[3]); kf[7] = k_read<8192>(ad[3]);
      QKStep<0, 2 * KS>::template run<KS>(kf, ad, qf, A0, A1);
      SBAR();
      const bool dead = tile_mask<MK>(A0, A1, g, kbase, cls, mk);
      ParState pr; pr.mxa = NEGS; pr.mxb = NEGS; pr.alpha = 1.0f; pr.mc = 0.f;
      ParAlone<0>::run(A0, A1, pr, st, dead, cs); alF = pr.alpha; }
    int j = 1;
    for (; j + 1 < nt; j += 2) {
        stream_step<KS, MK, 1>(lds, K, V, ldk, ldv, kt0, j, nt, wave, dof, qf, ad, va, g, mk, cs, O, st, A0, A1, B0, B1, alF);
        stream_step<KS, MK, 0>(lds, K, V, ldk, ldv, kt0, j + 1, nt, wave, dof, qf, ad, va, g, mk, cs, O, st, B0, B1, A0, A1, alF);
    }
    unsigned vslot = 0u;
    if (j < nt) {
        stream_step<KS, MK, 1>(lds, K, V, ldk, ldv, kt0, j, nt, wave, dof, qf, ad, va, g, mk, cs, O, st, A0, A1, B0, B1, alF);
        A0 = B0; A1 = B1; vslot = 16384u;
    }
    asm volatile("s_waitcnt vmcnt(0)" ::: "memory");
    __syncthreads();
#pragma unroll
    for (int i = 0; i < 8; ++i) va[i] += vslot;
    stream_tail(va, O, st, A0, A1, alF);
    __syncthreads();
}
struct MaskCausal { static constexpr int KPRE = 8; int qpos, wlo;
    __device__ __forceinline__ int prep(int kbase) { if (kbase > wlo + 31) return 0; return (kbase + 63 <= wlo) ? 1 : 2; }
    __device__ __forceinline__ bool valid(int key) const { return key <= qpos; }
    __device__ __forceinline__ bool lane_on() const { return true; } };
struct MaskMoba { static constexpr int KPRE = 4; int qpos, wlo, own; unsigned bits; bool lanebit, diag;
    __device__ __forceinline__ int prep(int kbase) { const int blk = kbase >> 8;
        if (blk == own) { diag = true; if (kbase > wlo + 31) return 0; return (kbase + 63 <= wlo) ? 1 : 2; }
        diag = false; lanebit = (bits >> blk) & 1u; return __all(lanebit) ? 1 : (__any(lanebit) ? 3 : 0); }
    __device__ __forceinline__ bool valid(int key) const { return key <= qpos; }
    __device__ __forceinline__ bool lane_on() const { return lanebit; } };
struct MaskSel { static constexpr int KPRE = 4; int qpos, cur; unsigned long long bits; bool lanebit, diag;
    __device__ __forceinline__ int prep(int kbase) { const int kt = kbase >> 6;
        if (kt == cur) { diag = true; return 2; }
        diag = false; lanebit = (bits >> kt) & 1ull; return __all(lanebit) ? 1 : (__any(lanebit) ? 3 : 0); }
    __device__ __forceinline__ bool valid(int key) const { return key <= qpos; }
    __device__ __forceinline__ bool lane_on() const { return lanebit; } };
struct MaskWin { static constexpr int KPRE = 4; int qpos, wlo;
    __device__ __forceinline__ int prep(int kbase) { const int hi = wlo + 31; if (kbase > hi || kbase + 63 <= wlo - 512) return 0; return (kbase + 63 <= wlo && kbase > hi - 512) ? 1 : 2; }
    __device__ __forceinline__ bool valid(int key) const { return key <= qpos && key > qpos - 512; }
    __device__ __forceinline__ bool lane_on() const { return true; } };
struct MaskCmp { static constexpr int KPRE = 4; int qpos, wlo;
    __device__ __forceinline__ int prep(int kbase) { if (16 * kbase > wlo) return 0; return (16 * (kbase + 63) + 31 <= wlo) ? 1 : 2; }
    __device__ __forceinline__ bool valid(int key) const { return 16 * key + 31 <= qpos; }
    __device__ __forceinline__ bool lane_on() const { return true; } };

constexpr float LOG2E = 1.44269504088896340736f;
__device__ __forceinline__ void store_ot_bf16(const f32x16 (&O)[4], float sc, bf16_t* dst, int h) {
#pragma unroll
    for (int c = 0; c < 4; ++c)
#pragma unroll
        for (int q = 0; q < 4; q += 2) {
            u32x2 a, b;
            a.x = cvt_pk_bf16(O[c][4 * q] * sc, O[c][4 * q + 1] * sc); a.y = cvt_pk_bf16(O[c][4 * q + 2] * sc, O[c][4 * q + 3] * sc);
            b.x = cvt_pk_bf16(O[c][4 * q + 4] * sc, O[c][4 * q + 5] * sc); b.y = cvt_pk_bf16(O[c][4 * q + 6] * sc, O[c][4 * q + 7] * sc);
            auto r0 = __builtin_amdgcn_permlane32_swap(a.x, b.x, false, false); a.x = r0[0]; b.x = r0[1];
            auto r1 = __builtin_amdgcn_permlane32_swap(a.y, b.y, false, false); a.y = r1[0]; b.y = r1[1];
            *(u32x4*)(dst + 32 * c + 8 * (q + h)) = (u32x4){a.x, a.y, b.x, b.y}; }
}
#define ZERO16 (f32x16){0.f, 0.f, 0.f, 0.f, 0.f, 0.f, 0.f, 0.f, 0.f, 0.f, 0.f, 0.f, 0.f, 0.f, 0.f, 0.f}

__device__ __forceinline__ void phase_kmean(const Frame& F) {
    const bf16_t* qkv = (const bf16_t*)(F.ws + WS_QKV); bf16_t* km = (bf16_t*)(F.ws + WS_KMEAN);
    LAS float* part = (LAS float*)(F.lds + MISC_OFF + MO_GEN);
    for (int base = 2 * F.bid; base < NB * 8 * 16; base += 2 * F.G) {
        const int it = base + (F.wave >> 2), quarter = F.wave & 3, blk = it & 15, bh = it >> 4, b = bh >> 3, hh = bh & 7, rg = F.lane >> 4, ch = F.lane & 15;
        const bf16_t* p = qkv + ((size_t)b * SEQ + 256 * blk + 64 * quarter + 16 * rg) * N0 + 4096 + hh * 128 + 8 * ch;
        float s[8] = {0.f, 0.f, 0.f, 0.f, 0.f, 0.f, 0.f, 0.f};
        u32x4 q[16];
#pragma unroll
        for (int i = 0; i < 16; ++i) q[i] = *(const u32x4*)(p + (size_t)i * N0);
#pragma unroll
        for (int i = 0; i < 16; ++i) { s[0] += bflo(q[i].x); s[1] += bfhi(q[i].x); s[2] += bflo(q[i].y); s[3] += bfhi(q[i].y); s[4] += bflo(q[i].z); s[5] += bfhi(q[i].z); s[6] += bflo(q[i].w); s[7] += bfhi(q[i].w); }
#pragma unroll
        for (int j = 0; j < 8; ++j) { s[j] += swz_xor<16>(s[j]); s[j] = sum32(s[j]); }
        __syncthreads();
        if (F.lane < 16) {
#pragma unroll
            for (int j = 0; j < 8; ++j) part[F.wave * 128 + 8 * ch + j] = s[j]; }
        __syncthreads();
        if (quarter == 0 && F.lane < 16) {
            float t[8];
#pragma unroll
            for (int j = 0; j < 8; ++j) t[j] = ((part[F.wave * 128 + 8 * ch + j] + part[(F.wave + 1) * 128 + 8 * ch + j]) + (part[(F.wave + 2) * 128 + 8 * ch + j] + part[(F.wave + 3) * 128 + 8 * ch + j])) * (1.0f / 256.0f);
            u32x4 w; w.x = cvt_pk_bf16(t[0], t[1]); w.y = cvt_pk_bf16(t[2], t[3]); w.z = cvt_pk_bf16(t[4], t[5]); w.w = cvt_pk_bf16(t[6], t[7]);
            *(u32x4*)(km + ((size_t)bh * 32 + blk) * 128 + 8 * ch) = w; unsigned z = 0u; asm volatile("" : "+v"(z)); *(u32x4*)(km + ((size_t)bh * 32 + 16 + blk) * 128 + 8 * ch) = (u32x4){z, z, z, z}; }
    }
}

__device__ __forceinline__ void diff_unit(const Frame& F0, const Args& A, int b, int hh, int qb) {
    Frame F = F0; F.lane = fresh_lane(); F.tid = F.wave * 64 + F.lane; { unsigned long long w_ = (unsigned long long)F0.ws; asm volatile("" : "+s"(w_)); F.ws = (unsigned char*)(GAS unsigned char*)w_; }
    const bf16_t* qkv = (const bf16_t*)(F.ws + WS_QKV); bf16_t* att = (bf16_t*)(F.ws + WS_ATT);
    const LaneGeo g = lane_geo(F.lane);
    const int rg = F.wave & 3, map = F.wave >> 2, wlo = 128 * qb + 32 * rg, pos = wlo + g.r; const size_t tok = (size_t)b * SEQ + pos;
    bf16x8 qf[4];
#pragma unroll
    for (int ks = 0; ks < 4; ++ks) qf[ks] = *(const bf16x8*)(qkv + tok * N0 + hh * 128 + 64 * map + 16 * ks + 8 * g.h);
    f32x16 O[4] = {ZERO16, ZERO16, ZERO16, ZERO16}; SoftState st; st.m = NEGS; st.l = 0.f;
    MaskCausal mk; mk.qpos = pos; mk.wlo = wlo;
    const bf16_t* Kp = qkv + (size_t)b * SEQ * N0 + 1024 + hh * 128; const bf16_t* Vp = qkv + (size_t)b * SEQ * N0 + 2048 + hh * 128;
    attn_stream<4, MaskCausal>(F.lds, Kp, Vp, N0, N0, 0, 2 * qb + 2, F.wave, F.lane, qf, 4 * map, g, mk, 0.125f * LOG2E, O, st);
    const float inv = 1.0f / sum32(st.l);
    LAS float* xch = (LAS float*)(F.lds + rg * 16384);
    if (map == 1) {
#pragma unroll
        for (int c = 0; c < 4; ++c)
#pragma unroll
            for (int i = 0; i < 16; ++i) xch[(c * 16 + i) * 64 + F.lane] = O[c][i] * inv;
    }
    __syncthreads();
    if (map == 0) {
        const float sa = wave_sum(inp(2)[F.lane] * inp(3)[F.lane]), sb = wave_sum(inp(4)[F.lane] * inp(5)[F.lane]);
        const float lam = __expf(sa) - __expf(sb) + 0.2f;
        float ss = 0.f;
#pragma unroll
        for (int c = 0; c < 4; ++c) {
#pragma unroll
            for (int i = 0; i < 16; ++i) { const float o = O[c][i] * inv - lam * xch[(c * 16 + i) * 64 + F.lane]; O[c][i] = o; ss += o * o; }
            asm volatile("" ::: "memory"); }
        ss = sum32(ss);
        const float rn = 0.8f / sqrtf(ss * (1.0f / 128.0f) + LN_EPS);
        const float* sg = inp(6);
#pragma unroll
        for (int c = 0; c < 4; ++c) {
#pragma unroll
            for (int q = 0; q < 4; ++q) { const f32x4 gg = *(const f32x4*)(sg + 32 * c + 8 * q + 4 * g.h);
                O[c][4 * q] *= gg[0]; O[c][4 * q + 1] *= gg[1]; O[c][4 * q + 2] *= gg[2]; O[c][4 * q + 3] *= gg[3]; }
            asm volatile("" ::: "memory"); }
        store_ot_bf16(O, rn, att + tok * DM + hh * 128, g.h);
    }
    __syncthreads();
}
__device__ __forceinline__ void moba_unit(const Frame& F0, int b, int hh, int qb) {
    Frame F = F0; F.lane = fresh_lane(); F.tid = F.wave * 64 + F.lane; { unsigned long long w_ = (unsigned long long)F0.ws; asm volatile("" : "+s"(w_)); F.ws = (unsigned char*)(GAS unsigned char*)w_; }
    const bf16_t* qkv = (const bf16_t*)(F.ws + WS_QKV); bf16_t* att = (bf16_t*)(F.ws + WS_ATT);
    const LaneGeo g = lane_geo(F.lane);
    const int wlo = 256 * qb + 32 * F.wave, pos = wlo + g.r; const size_t tok = (size_t)b * SEQ + pos;
    bf16x8 qf[8];
#pragma unroll
    for (int ks = 0; ks < 8; ++ks) qf[ks] = *(const bf16x8*)(qkv + tok * N0 + 3072 + hh * 128 + 16 * ks + 8 * g.h);
    MaskMoba mk; mk.qpos = pos; mk.wlo = wlo; mk.own = qb; mk.bits = 0u; mk.lanebit = false; mk.diag = false;
    if (qb > 0) {
        const bf16_t* km = (const bf16_t*)(F.ws + WS_KMEAN) + (size_t)(b * 8 + hh) * 32 * 128;
        __syncthreads();
        { const int r = F.tid >> 4, ch = F.tid & 15; *(LAS u32x4*)(F.lds + offb(r, ch)) = *(const u32x4*)(km + r * 128 + 8 * ch); }
        __syncthreads();
        f32x16 G = ZERO16;
#pragma unroll
        for (int ks = 0; ks < 8; ++ks) { const unsigned o = g.krow + (((2 * ks + g.h) ^ g.kx) << 4); G = MFMA32(*(const LAS bf16x8*)(F.lds + o), qf[ks], G); }
        float gv[16];
#pragma unroll
        for (int i = 0; i < 8; ++i) { const float a = G[i], o = partner32(a, g.h); const int nb = (i & 3) + 8 * (i >> 2); gv[nb] = g.h ? o : a; gv[nb + 4] = g.h ? a : o; }
        unsigned picked = 0u, bits = 0u;
        for (int it = 0; it < 3; ++it) { float best = -3e38f; int bi = 0;
#pragma unroll
            for (int n = 0; n < 16; ++n) { const float v = n < qb ? gv[n] : NEGF; if (!((picked >> n) & 1u) && v > best) { best = v; bi = n; } }
            picked |= 1u << bi; if (bi < qb) bits |= 1u << bi; }
        mk.bits = bits;
    }
    f32x16 O[4] = {ZERO16, ZERO16, ZERO16, ZERO16}; SoftState st; st.m = NEGS; st.l = 0.f;
    const bf16_t* Kp = qkv + (size_t)b * SEQ * N0 + 4096 + hh * 128; const bf16_t* Vp = qkv + (size_t)b * SEQ * N0 + 5120 + hh * 128;
    attn_stream<8, MaskMoba>(F.lds, Kp, Vp, N0, N0, 0, 4 * qb + 4, F.wave, F.lane, qf, 0, g, mk, 0.08838834764831845f * LOG2E, O, st);
    const float inv = 1.0f / sum32(st.l);
    store_ot_bf16(O, inv, att + tok * DM + 1024 + hh * 128, g.h);
}
__device__ __forceinline__ void phase_attn0(const Frame& F, const Args& A) {
    for (int k = 0; k * F.G < 1024; ++k) { const int w = F.bid; const int rk = k * F.G + ((k & 1) ? F.G - 1 - w : w);
#ifndef NO_DIFF
        if (rk < 1024) { const int qb = 31 - rk / 32, bh = rk % 32; diff_unit(F, A, bh >> 3, bh & 7, qb); }
#endif
    }
    for (int k = 0; k * F.G < 512; ++k) { const int w = F.bid; const int rk = k * F.G + ((k & 1) ? F.G - 1 - w : w);
#ifndef NO_MOBA
        if (rk < 512) { const int qb = 15 - rk / 32, bh = rk % 32; moba_unit(F, bh >> 3, bh & 7, qb); }
#endif
    }
}

__device__ __forceinline__ float gelu_tanh(float x) { const float u = 0.7978845608028654f * (x + 0.044715f * x * x * x); const float e = __expf(2.0f * u); return 0.5f * x * (2.0f - 2.0f / (1.0f + e)); }
__device__ __forceinline__ void phase_compress(const Frame& F) {
    unsigned char* ws = F.ws; const bf16_t* qkv = (const bf16_t*)(ws + WS_QKV);
    const LaneGeo g = lane_geo(F.lane);
    for (int it = F.bid; it < 128; it += F.G) {
        const int kv = it >> 6, bg = (it >> 3) & 7, tile = it & 7, b = bg >> 1, gi = bg & 1;
        const bf16_t* w1t = (const bf16_t*)(ws + (kv ? WS_W1VT : WS_W1KT)); const bf16_t* w2t = (const bf16_t*)(ws + (kv ? WS_W2VT : WS_W2KT));
        const float* peb = (const float*)(ws + WS_PEB) + kv * 128;
        bf16_t* outp = (bf16_t*)(ws + (kv ? WS_VCMP : WS_KCMP)) + (size_t)bg * 256 * 128;
        const int n = 32 * tile + g.r, col0 = (kv ? 2304 : 2048) + gi * 128;
        __syncthreads();
        f32x16 acc[4] = {ZERO16, ZERO16, ZERO16, ZERO16};
#pragma unroll 8
        for (int kk = 0; kk < 32; ++kk) { const int ks = 32 * F.wave + kk, tl = ks >> 3, d = 16 * (ks & 7) + 8 * g.h;
            int tp = 16 * n + tl; tp = tp < SEQ ? tp : SEQ - 1;
            const bf16x8 bq = *(const bf16x8*)(qkv + ((size_t)b * SEQ + tp) * N1 + col0 + d);
#pragma unroll
            for (int blk = 0; blk < 4; ++blk) { const bf16x8 aq = *(const bf16x8*)(w1t + ((((size_t)blk * 256 + ks) * 64 + F.lane) << 3)); acc[blk] = MFMA32(aq, bq, acc[blk]); } }
        LAS float* part = (LAS float*)(F.lds + F.wave * 16384);
#pragma unroll
        for (int blk = 0; blk < 4; ++blk)
#pragma unroll
            for (int i = 0; i < 16; ++i) part[(blk * 16 + i) * 64 + F.lane] = acc[blk][i];
        __syncthreads();
        LAS bf16_t* hidT = (LAS bf16_t*)(F.lds + MISC_OFF + MO_GEN);
        for (int i = 0; i < 8; ++i) { const int idx = F.tid + 512 * i, ln = idx & 63, ri = idx >> 6, blk = ri >> 4, reg = ri & 15;
            float s = 0.f;
#pragma unroll
            for (int w = 0; w < 8; ++w) s += ((LAS float*)(F.lds + w * 16384))[idx];
            const int hidden = 32 * blk + crow(reg, ln >> 5);
            s = gelu_tanh(s + peb[hidden]);
            hidT[hidden * 32 + (ln & 31)] = (bf16_t)(cvt_pk_bf16(s, 0.f) & 0xffffu); }
        __syncthreads();
        if (F.wave < 4) {
            const int ob = F.wave; f32x16 o = ZERO16;
#pragma unroll
            for (int ks = 0; ks < 8; ++ks) { const bf16x8 aq = *(const bf16x8*)(w2t + (size_t)(32 * ob + g.r) * 128 + 16 * ks + 8 * g.h);
                bf16x8 bq;
#pragma unroll
                for (int j = 0; j < 8; ++j) bq[j] = (short)hidT[(16 * ks + 8 * g.h + j) * 32 + g.r];
                o = MFMA32(aq, bq, o); }
            const bool dead = (n >= 255);
#pragma unroll
            for (int q = 0; q < 4; ++q) { u32x2 w; w.x = cvt_pk_bf16(o[4 * q], o[4 * q + 1]); w.y = cvt_pk_bf16(o[4 * q + 2], o[4 * q + 3]); if (dead) { w.x = 0u; w.y = 0u; }
                *(u32x2*)(outp + (size_t)n * 128 + 32 * ob + 8 * q + 4 * g.h) = w; }
        }
    }
}

__device__ __forceinline__ float sigmoid_f(float x) { float e = __expf(-x); asm volatile("" : "+v"(e)); float d = 1.0f + e; asm volatile("" : "+v"(d)); return __builtin_amdgcn_rcpf(d); }
__device__ __forceinline__ void nsa_unit(const Frame& F0, int b, int gi, int pt) {
    Frame F = F0; F.lane = fresh_lane(); F.tid = F.wave * 64 + F.lane; { unsigned long long w_ = (unsigned long long)F0.ws; asm volatile("" : "+s"(w_)); F.ws = (unsigned char*)(GAS unsigned char*)w_; }
    unsigned char* ws = F.ws; const bf16_t* qkv = (const bf16_t*)(ws + WS_QKV); const bf16_t* qrot = (const bf16_t*)(ws + WS_QROT); bf16_t* att = (bf16_t*)(ws + WS_ATT);
    const LaneGeo g = lane_geo(F.lane);
    const int head = 8 * gi + F.wave, t0 = 32 * pt, pos = t0 + g.r, cur = t0 >> 6; const size_t tok = (size_t)b * SEQ + pos;
    const float cs = 0.08838834764831845f * LOG2E;
#define NSA_GATE(br, name) float name; { int p_ = pos; asm volatile("" : "+v"(p_)); name = sigmoid_f(bf2f(qkv[((size_t)b * SEQ + p_) * N1 + 3584 + head * 3 + (br)])); }
    unsigned OTp[4][8];
    bf16x8 qf[8];
#pragma unroll
    for (int ks = 0; ks < 8; ++ks) qf[ks] = *(const bf16x8*)(qkv + tok * N1 + head * 128 + 16 * ks + 8 * g.h);
    __syncthreads();
    { const bf16_t* kc = (const bf16_t*)(ws + WS_KCMP) + (size_t)(b * 2 + gi) * 256 * 128; const bf16_t* vc = (const bf16_t*)(ws + WS_VCMP) + (size_t)(b * 2 + gi) * 256 * 128;
#pragma unroll
      for (int i = 0; i < 8; ++i) { const int piece = F.tid + 512 * i, row = piece >> 4, ch = piece & 15; const unsigned o = (row >> 6) * 16384 + offb(row & 63, ch);
          *(LAS u32x4*)(F.lds + o) = *(const u32x4*)(kc + row * 128 + 8 * ch); *(LAS u32x4*)(F.lds + 65536 + o) = *(const u32x4*)(vc + row * 128 + 8 * ch); } }
    __syncthreads();
    MaskCmp mc; mc.qpos = pos; mc.wlo = t0;
    SoftState sc_; sc_.m = NEGS; sc_.l = 0.f;
    { f32x16 O[4] = {ZERO16, ZERO16, ZERO16, ZERO16};
#pragma unroll 1
      for (int j = 0; j < 4; ++j) { const int cls = mc.prep(64 * j); if (cls) attn_tile<8, MaskCmp>(F.lds + j * 16384, (unsigned)(uintptr_t)(F.lds + 65536 + j * 16384), qf, 0, g, 64 * j, cls, mc, cs, O, sc_); }
      const float lt = sum32(sc_.l); const bool ok = pos >= 31; NSA_GATE(0, g0); const float sc = ok ? g0 * __builtin_amdgcn_rcpf(lt) : 0.f;
#pragma unroll
      for (int c = 0; c < 4; ++c)
#pragma unroll
          for (int i = 0; i < 8; ++i) OTp[c][i] = cvt_pk_bf16(O[c][2 * i] * sc, O[c][2 * i + 1] * sc);
      sc_.l = ok ? __builtin_amdgcn_rcpf(lt) : 0.f; }
    __syncthreads();
    { LAS float* slab = (LAS float*)(F.lds + 65536) + (F.wave * 32 + g.r) * 64; float prevx = 0.f;
#pragma unroll 1
      for (int j = 0; j < 4; ++j) {
          if (mc.prep(64 * j) == 0) {
#pragma unroll
              for (int gq = 0; gq < 8; ++gq) slab[(16 * j + 2 * gq + g.h) ^ g.r] = 0.f;
              prevx = 0.f; continue; }
          f32x16 S0, S1; qk_tile<8, true>(F.lds + j * 16384, qf, 0, g, cs, S0, S1);
#pragma unroll
          for (int sub = 0; sub < 2; ++sub)
#pragma unroll
              for (int q = 0; q < 4; ++q) { float p[4];
#pragma unroll
                  for (int e = 0; e < 4; ++e) { const int key = 64 * j + 32 * sub + 8 * q + 4 * g.h + e; const float s = sub ? S1[4 * q + e] : S0[4 * q + e]; p[e] = mc.valid(key) ? fast_exp2(s - sc_.m * cs) * sc_.l : 0.f; }
                  const float a = (p[0] + p[1]) + (p[2] + 0.5f * p[3]), cy = 0.5f * p[3], x = partner32(cy, g.h);
                  const float tot = a + (g.h ? x : prevx); prevx = x;
                  const int jb = 16 * j + 8 * sub + 2 * q + g.h; slab[jb ^ g.r] = tot; } } }
    __syncthreads();
    LAS unsigned* selm = (LAS unsigned*)(F.lds + MISC_OFF + MO_GEN);
    { const int jb = F.lane;
      for (int pi = 0; pi < 4; ++pi) { const int pp = 4 * F.wave + pi; float v = 0.f;
#pragma unroll
          for (int w = 0; w < 8; ++w) v += ((LAS float*)(F.lds + 65536))[(w * 32 + pp) * 64 + (jb ^ pp)];
          const bool allowed = jb <= cur, forced = (jb == 0) || (jb == cur) || (jb == cur - 1);
          const float val = allowed ? (forced ? 1e4f : v) : NEGF;
          int rank = 0;
#pragma unroll
          for (int i = 0; i < 64; ++i) { const float vi = __int_as_float(__builtin_amdgcn_readlane(__float_as_int(val), i)); rank += (vi > val || (vi == val && i < jb)) ? 1 : 0; }
          const unsigned long long m = __ballot(rank < 16 && allowed);
          if (F.lane == 0) { selm[2 * pp] = (unsigned)m; selm[2 * pp + 1] = (unsigned)(m >> 32); } } }
    __syncthreads();
    LAS unsigned* park = (LAS unsigned*)(F.lds + 65536 + F.wave * 8192) + F.lane;
#pragma unroll
    for (int c = 0; c < 4; ++c)
#pragma unroll
        for (int i = 0; i < 8; ++i) park[(c * 8 + i) * 64] = OTp[c][i];
    { int p2 = pos; asm volatile("" : "+v"(p2)); const size_t tok2 = (size_t)b * SEQ + p2;
#pragma unroll
      for (int ks = 0; ks < 8; ++ks) qf[ks] = *(const bf16x8*)(qrot + tok2 * DM + head * 128 + 16 * ks + 8 * g.h); }
    { MaskSel ms; ms.qpos = pos; ms.cur = cur; ms.bits = (unsigned long long)selm[2 * g.r] | ((unsigned long long)selm[2 * g.r + 1] << 32); ms.lanebit = false; ms.diag = false;
      f32x16 O[4] = {ZERO16, ZERO16, ZERO16, ZERO16}; SoftState st; st.m = NEGS; st.l = 0.f;
      const bf16_t* Kp = qkv + (size_t)b * SEQ * N1 + 2560 + gi * 128; const bf16_t* Vp = qkv + (size_t)b * SEQ * N1 + 2816 + gi * 128;
      attn_stream<8, MaskSel>(F.lds, Kp, Vp, N1, N1, 0, cur + 1, F.wave, F.lane, qf, 0, g, ms, cs, O, st);
      NSA_GATE(1, g1); const float sc = g1 * __builtin_amdgcn_rcpf(sum32(st.l));
      LAS unsigned* park2 = (LAS unsigned*)(F.lds + 65536 + F.wave * 8192) + fresh_lane();
#pragma unroll
      for (int c = 0; c < 4; ++c)
#pragma unroll
          for (int i = 0; i < 8; ++i) { const unsigned w = park2[(c * 8 + i) * 64]; park2[(c * 8 + i) * 64] = cvt_pk_bf16(bflo(w) + O[c][2 * i] * sc, bfhi(w) + O[c][2 * i + 1] * sc); } }
    { MaskWin mw; mw.qpos = pos; mw.wlo = t0;
      f32x16 O[4] = {ZERO16, ZERO16, ZERO16, ZERO16}; SoftState st; st.m = NEGS; st.l = 0.f;
      const int kt0 = t0 >= 511 ? (t0 - 511) >> 6 : 0;
      const bf16_t* Kp = qkv + (size_t)b * SEQ * N1 + 3072 + gi * 128; const bf16_t* Vp = qkv + (size_t)b * SEQ * N1 + 3328 + gi * 128;
      attn_stream<8, MaskWin>(F.lds, Kp, Vp, N1, N1, kt0, cur - kt0 + 1, F.wave, F.lane, qf, 0, g, mw, cs, O, st);
      NSA_GATE(2, g2); const float sc = g2 * __builtin_amdgcn_rcpf(sum32(st.l));
      int p3 = pos; asm volatile("" : "+v"(p3));
      bf16_t* dst = att + ((size_t)b * SEQ + p3) * DM + head * 128;
      const int ln3 = fresh_lane(), h3 = ln3 >> 5; LAS unsigned* park3 = (LAS unsigned*)(F.lds + 65536 + F.wave * 8192) + ln3;
#pragma unroll
      for (int c = 0; c < 4; ++c)
#pragma unroll
          for (int q = 0; q < 4; q += 2) { u32x2 a, b;
              { const unsigned w0 = park3[(c * 8 + 2 * q) * 64], w1 = park3[(c * 8 + 2 * q + 1) * 64];
                a.x = cvt_pk_bf16(bflo(w0) + O[c][4 * q] * sc, bfhi(w0) + O[c][4 * q + 1] * sc); a.y = cvt_pk_bf16(bflo(w1) + O[c][4 * q + 2] * sc, bfhi(w1) + O[c][4 * q + 3] * sc); }
              { const unsigned w0 = park3[(c * 8 + 2 * q + 2) * 64], w1 = park3[(c * 8 + 2 * q + 3) * 64];
                b.x = cvt_pk_bf16(bflo(w0) + O[c][4 * q + 4] * sc, bfhi(w0) + O[c][4 * q + 5] * sc); b.y = cvt_pk_bf16(bflo(w1) + O[c][4 * q + 6] * sc, bfhi(w1) + O[c][4 * q + 7] * sc); }
              auto r0 = __builtin_amdgcn_permlane32_swap(a.x, b.x, false, false); a.x = r0[0]; b.x = r0[1];
              auto r1 = __builtin_amdgcn_permlane32_swap(a.y, b.y, false, false); a.y = r1[0]; b.y = r1[1];
              *(u32x4*)(dst + 32 * c + 8 * (q + h3)) = (u32x4){a.x, a.y, b.x, b.y}; } }
}
__device__ __forceinline__ void phase_attn1(const Frame& F) {
    for (int k = 0; k * F.G < 1024; ++k) { const int w = F.bid; const int rk = k * F.G + ((k & 1) ? F.G - 1 - w : w);
        if (rk < 1024) { const int pt = 127 - rk / 8, bg = rk % 8; nsa_unit(F, bg >> 1, bg & 1, pt); } }
}

constexpr int N_LAUNCHES = MK_N_LAUNCHES;
__global__ void __launch_bounds__(512, 2) fwd(Args args) {
    extern __shared__ __attribute__((aligned(16))) unsigned char lds_raw[];
    Frame F;
    F.lds = (LAS unsigned char*)lds_raw; F.ws = args.ws; F.ctl = (unsigned*)(args.ws + WS_CTL);
    F.tid = threadIdx.x; F.lane = F.tid & 63; F.wave = __builtin_amdgcn_readfirstlane(F.tid >> 6); F.G = gridDim.x; F.bid = blockIdx.x;
    const int wave0 = F.wave, bid0 = F.bid, grid0 = F.G;
#define PHASE_TID() do { { int w_ = wave0, b_ = bid0, g_ = grid0; asm volatile("" : "+s"(w_), "+s"(b_), "+s"(g_)); F.wave = w_; F.bid = b_; F.G = g_; } F.lane = fresh_lane(); F.tid = F.wave * 64 + F.lane; unsigned long long w_ = (unsigned long long)ws0; asm volatile("" : "+s"(w_)); F.ws = (unsigned char*)(GAS unsigned char*)w_; ws = F.ws; F.ctl = (unsigned*)(F.ws + WS_CTL); } while (0)
    for (int u = F.tid; u < (LDS_BYTES - MISC_OFF) / 4; u += 512) ((LAS unsigned*)(F.lds + MISC_OFF))[u] = 0u;
    __syncthreads();
    XcdBarrier bar; bar.bar = F.ctl + CW_BAR; bar.x = 0; bar.st = nullptr; bar.wave = F.wave;
    if (N_LAUNCHES == 1) { bar = xcd_barrier_post(F.ctl + CW_BAR, (volatile LAS unsigned*)(F.lds + MISC_OFF + MO_BARW)); bar.wave = F.wave; }
    const int lo = args.ph_lo, hi = args.ph_hi;
#ifndef PHM
#define PHM 0x1ffff
#endif
#ifndef REPM
#define REPM 0
#endif
#define REP(j) for (int rep_ = 0; rep_ < (((REPM >> (j)) & 1) ? 2 : 1); ++rep_)
#define IN(k) (((PHM >> ((k) == 0 ? 0 : (k) < 9 ? (k) : (k) - 8 + 8)) & 1) && lo <= (k) && (k) < hi)
#define SEAM(k) do { if (IN(k) && IN((k) + 1)) xcd_barrier(bar); } while (0)
    unsigned char* const ws0 = args.ws; unsigned char* ws = ws0;
    if (IN(0)) REP(0) { PHASE_TID(); p0_prologue(F, args); }
    SEAM(0);
    for (int layer = 0; layer < 2; ++layer) {
        const int pb = 1 + 8 * layer;
        if (IN(pb)) REP(1) {
            PHASE_TID();
            const int N = layer ? N1 : N0;
            const int NW = layer ? F.G : F.G - NCONV;
            if (F.bid < NW) {
                pg8::DenseOrder S; S.init(ws + WS_XB, ws + (layer ? WS_WCIN : WS_WAIN), T, N, DM, NW, F.bid);
                EpiQKV E; E.out = (bf16_t*)(ws + WS_QKV); E.ldo = N; E.qrot = (bf16_t*)(ws + WS_QROT); E.rope128 = (const f32x4*)(ws + WS_ROPE128); E.rope64 = (const f32x4*)(ws + WS_ROPE64); E.layer = layer;
                pg8::gemm_phase<EpiQKV, pg8::DenseOrder>(F.lds, F.tid, 2 * DM, S, E);
            }
            if (layer == 0) {
                if (F.bid >= NW) {
                    cvt_pipeline(F, args, -1, 1, 0, 0, cvi::O1, cvi::O2, (F.bid - NW) * 8 + F.wave, NCONV * 8);
                    cvt_pipeline(F, args, -1, 1, 0, 0, cvi::O6, cvi::O7, (F.bid - NW) * 8 + F.wave, NCONV * 8);
                    pe_bias(F, args); }
                cvt_dynamic(F, args, 0, NW, F.bid < NW, false); }
        }
        SEAM(pb);
        if (IN(pb + 1)) REP(2) { PHASE_TID(); if (layer == 0) phase_kmean(F); else phase_compress(F); }
        SEAM(pb + 1);
        if (IN(pb + 2)) REP(3) { PHASE_TID();
            if (layer == 0) { const int NW = F.G - NCONV;
                if (F.bid < NW) { F.G = NW; phase_attn0(F, args); }
                cvt_dynamic(F, args, 1, NW, F.bid < NW, false); }
            else phase_attn1(F); }
        SEAM(pb + 2);
        if (IN(pb + 3)) REP(4) {
            PHASE_TID();
            pg8::DenseOrder S; S.init(ws + WS_ATT, ws + (layer ? WS_WCOUT : WS_WAOUT), T, DM, DM, F.G, F.bid);
            EpiRes E; E.res = (const bf16_t*)(ws + WS_XB); E.out = (bf16_t*)(ws + WS_Y1);
            pg8::gemm_phase<EpiRes, pg8::DenseOrder>(F.lds, F.tid, 2 * DM, S, E);
        }
        SEAM(pb + 3);
        if (IN(pb + 4)) { PHASE_TID(); if (layer == 0) cvt_dynamic(F, args, 0, 0, false, true); phase_ln_router(F, args, layer); }
        SEAM(pb + 4);
        if (IN(pb + 5)) REP(6) {
            PHASE_TID();
            const MoeTabs tb = build_moe_tabs(F, layer);
            GuOrder S; S.list = (const int*)(ws + WS_LIST); S.tb = tb; S.G = F.G; S.c = F.bid;
            S.A = (const char*)(ws + WS_HB8); S.W = (const char*)(ws + WS_WGU + (size_t)layer * 65 * WGU_E); S.RB = DM;
            EpiGU8 E; E.H = (bf16_t*)(ws + WS_HBUF); pg8::gemm_phase<EpiGU8, GuOrder, true>(F.lds, F.tid, DM, S, E);
        }
        SEAM(pb + 5);
        if (IN(pb + 6)) REP(7) {
            PHASE_TID();
            const MoeTabs tb = build_moe_tabs(F, layer);
            DnOrder S; S.H = (const char*)(ws + WS_HBUF); S.tb = tb; S.G = F.G; S.c = F.bid; S.W = (const char*)(ws + WS_WDN + (size_t)layer * 65 * WDN_E); S.RB = 2 * EDIM;
            EpiDN E; E.Y = (bf16_t*)(ws + WS_YBUF); pg8::gemm_phase<EpiDN, DnOrder, false>(F.lds, F.tid, 2 * EDIM, S, E);
        }
        SEAM(pb + 6);
        if (IN(pb + 7)) REP(8) { PHASE_TID(); const MoeTabs tb = build_moe_tabs(F, layer); phase_combine_ln(F, args, layer, tb); }
        SEAM(pb + 7);
    }
#undef IN
#undef SEAM
}

extern "C" void kernel_launch(void* const* d_in, const int* in_sizes, int n_in, void* d_out, int out_size, void* d_ws, size_t ws_size, hipStream_t stream) {
    static int grid = 0;
    if (grid == 0) {
        if (n_in != 26 || out_size != T * DM || ws_size < WS_END) { fprintf(stderr, "kernel_launch: unexpected problem (n_in %d, out %d, ws %zu < %zu)\n", n_in, out_size, ws_size, (size_t)WS_END); grid = -1; return; }
        int dev = 0, cus = 0, per_cu = 0;
        if (hipGetDevice(&dev) != hipSuccess || hipDeviceGetAttribute(&cus, hipDeviceAttributeMultiprocessorCount, dev) != hipSuccess) { grid = -1; return; }
        if (hipFuncSetAttribute((const void*)fwd, hipFuncAttributeMaxDynamicSharedMemorySize, LDS_BYTES) != hipSuccess) { fprintf(stderr, "kernel_launch: hipFuncSetAttribute failed\n"); grid = -1; return; }
        if (hipOccupancyMaxActiveBlocksPerMultiprocessor(&per_cu, (const void*)fwd, 512, LDS_BYTES) != hipSuccess || per_cu < 1) fprintf(stderr, "kernel_launch: occupancy query reports %d\n", per_cu);
        (void)hipGetLastError();
        grid = cus;
    }
    if (grid < 0) return;
    if (hipMemsetAsync((char*)d_ws + WS_CTL, 0, CTL_USED, stream) != hipSuccess) return;
    Args a{};
    for (int i = 0; i < 26; ++i) a.in[i] = (const float*)d_in[i];
    a.out = (float*)d_out; a.ws = (unsigned char*)d_ws;
    if (N_LAUNCHES == 1) { a.ph_lo = 0; a.ph_hi = NPHASE; hipLaunchKernelGGL(fwd, dim3(grid), dim3(512), LDS_BYTES, stream, a); }
    else { for (int p = 0; p < NPHASE; ++p) { a.ph_lo = p; a.ph_hi = p + 1; hipLaunchKernelGGL(fwd, dim3(grid), dim3(512), LDS_BYTES, stream, a); } }
}
```
